# Optimizing an MI355X kernel written in HIP

```python
import math
import jax, jax.numpy as jnp
from jax import lax
import numpy as np

D_MODEL = 1024
BATCH = 8
SEQ = 2048
DEPTH = 1

D_MIX = D_MODEL
ATTN_HEADS = 8
HEAD_DIM = 64
D_ATTN = ATTN_HEADS * HEAD_DIM
SGU_GROUPS = 4
SGU_CH = 128
D_SGU = SGU_GROUPS * SGU_CH
D_IN_PROJ = 3 * D_ATTN + 2 * D_SGU
CHUNK = 128
DILATED = ((128, 1), (512, 4), (2048, 16))
BLK = 128
NUM_BUCKETS = 32
MAX_DISTANCE = 2048
PEER_HEADS = 8
PEER_KEYS = 128
PEER_EXPERTS = PEER_KEYS * PEER_KEYS
PEER_D_KEY = 256
PEER_TOPK = 16
PEER_CHUNK = 128
EPS = 1e-6
NEG = -1e30

kernel_name = "hymba_sgu_dilated_attn_peer_layer"


def _rms(x, w):
    xf = x.astype(jnp.float32)
    y = xf * lax.rsqrt(jnp.mean(xf * xf, axis=-1, keepdims=True) + EPS)
    return (y * w.astype(jnp.float32)).astype(x.dtype)


def _t5_bucket(dist):
    max_exact = NUM_BUCKETS // 2
    d_f = jnp.maximum(dist, max_exact).astype(jnp.float32)
    large = max_exact + (jnp.log(d_f / max_exact) / math.log(MAX_DISTANCE / max_exact)
                         * (NUM_BUCKETS - max_exact)).astype(jnp.int32)
    large = jnp.minimum(large, NUM_BUCKETS - 1)
    return jnp.where(dist < max_exact, dist, large)


def _dilated_window_attention(q, k, v, rel_bias, window, dil):
    b, s, h, dh = q.shape
    w_sub = window // dil
    assert w_sub <= BLK
    L = s // dil
    nblk = -(-L // BLK)
    Lp = nblk * BLK

    def to_res(t):
        return t.reshape(b, L, dil, h, dh).transpose(0, 2, 1, 3, 4).reshape(b * dil, L, h, dh)

    qr, kr, vr = to_res(q), to_res(k), to_res(v)
    qb = jnp.pad(qr, ((0, 0), (0, Lp - L), (0, 0), (0, 0))).reshape(b * dil, nblk, BLK, h, dh)

    def kv_blocks(t):
        tp = jnp.pad(t, ((0, 0), (BLK, Lp - L), (0, 0), (0, 0))).reshape(b * dil, nblk + 1, BLK, h, dh)
        return jnp.concatenate([tp[:, :-1], tp[:, 1:]], axis=2)

    kb, vb = kv_blocks(kr), kv_blocks(vr)
    logits = jnp.einsum('bnqhd,bnkhd->bnhqk', qb, kb).astype(jnp.float32) * (HEAD_DIM ** -0.5)
    qi = jnp.arange(BLK)[:, None]
    kj = jnp.arange(2 * BLK)[None, :]
    rel = BLK + qi - kj
    bias = rel_bias[_t5_bucket(jnp.maximum(rel, 0) * dil)]
    logits = logits + bias.transpose(2, 0, 1).astype(jnp.float32)[None, None]
    kpos = jnp.arange(nblk)[:, None, None] * BLK - BLK + kj[None]
    valid = (rel >= 0)[None] & (rel <= w_sub)[None] & (kpos >= 0)
    logits = jnp.where(valid[None, :, None], logits, NEG)
    m = jnp.max(logits, axis=-1, keepdims=True)
    p = jnp.exp(logits - m)
    denom = jnp.sum(p, axis=-1, keepdims=True)
    o = jnp.einsum('bnhqk,bnkhd->bnqhd', p, vb.astype(jnp.float32)) / denom.transpose(0, 1, 3, 2, 4)
    lse = (m + jnp.log(denom))[..., 0].transpose(0, 1, 3, 2)
    o = o.reshape(b * dil, Lp, h, dh)[:, :L].reshape(b, dil, L, h, dh).transpose(0, 2, 1, 3, 4).reshape(b, s, h, dh)
    lse = lse.reshape(b * dil, Lp, h)[:, :L].reshape(b, dil, L, h).transpose(0, 2, 1, 3).reshape(b, s, h)
    return o, lse


def _spatial_gating(u, va, norm_w, w_s, b_s):
    b, s, _ = u.shape
    nc = s // CHUNK
    u = u.reshape(b, nc, CHUNK, SGU_GROUPS, SGU_CH)
    va = _rms(va.reshape(b, nc, CHUNK, SGU_GROUPS, SGU_CH), norm_w)
    w_masked = w_s * jnp.tril(jnp.ones((CHUNK, CHUNK), w_s.dtype))[None]
    spatial = jnp.einsum('gts,bnsgc->bntgc', w_masked, va) + b_s.T[None, None, :, :, None]
    return (u * spatial).reshape(b, s, D_SGU)


def _peer(xn, w_query, keys1, keys2, u_tab, v_tab):
    b, s, d = xn.shape
    t = b * s
    half = PEER_D_KEY // 2
    xf = xn.reshape(t, d)
    q = (xf @ w_query).reshape(t, PEER_HEADS, PEER_D_KEY)
    s1 = jnp.einsum('thd,hkd->thk', q[..., :half], keys1).astype(jnp.float32)
    s2 = jnp.einsum('thd,hkd->thk', q[..., half:], keys2).astype(jnp.float32)
    v1, i1 = lax.top_k(s1, PEER_TOPK)
    v2, i2 = lax.top_k(s2, PEER_TOPK)
    cand = (v1[..., :, None] + v2[..., None, :]).reshape(t, PEER_HEADS, PEER_TOPK * PEER_TOPK)
    cidx = (i1[..., :, None] * PEER_KEYS + i2[..., None, :]).reshape(t, PEER_HEADS, PEER_TOPK * PEER_TOPK)
    best, pos = lax.top_k(cand, PEER_TOPK)
    idx = jnp.take_along_axis(cidx, pos, axis=-1)
    gate = jax.nn.softmax(best, axis=-1)
    n_chunks = t // PEER_CHUNK
    n_sel = PEER_HEADS * PEER_TOPK

    def expert_block(args):
        xc, ic, gc = args
        u = jnp.take(u_tab, ic, axis=0)
        act = jax.nn.gelu(jnp.einsum('cd,ced->ce', xc, u).astype(jnp.float32))
        vv = jnp.take(v_tab, ic, axis=0)
        return jnp.einsum('ce,ced->cd', gc * act, vv.astype(jnp.float32)).astype(xc.dtype)

    y = lax.map(expert_block, (xf.reshape(n_chunks, PEER_CHUNK, d),
                               idx.reshape(n_chunks, PEER_CHUNK, n_sel),
                               gate.reshape(n_chunks, PEER_CHUNK, n_sel)))
    return y.reshape(b, s, d)


def setup_inputs(seed: int = 0) -> dict:
    key = jax.random.key(seed)
    ks = jax.random.split(key, 20)
    f32 = jnp.float32
    nrm = lambda k, shape, scale: jax.random.normal(k, shape, f32) * scale
    gain = lambda k, shape: 1.0 + 0.05 * jax.random.normal(k, shape, f32)
    return {
        "x": nrm(ks[0], (BATCH, SEQ, D_MODEL), 1.0),
        "ln1_w": gain(ks[1], (DEPTH, D_MODEL)),
        "w_in": nrm(ks[2], (DEPTH, D_MODEL, D_IN_PROJ), D_MODEL ** -0.5),
        "q_norm_w": gain(ks[3], (DEPTH, HEAD_DIM)),
        "k_norm_w": gain(ks[4], (DEPTH, HEAD_DIM)),
        "sgu_norm_w": gain(ks[5], (DEPTH, SGU_GROUPS, SGU_CH)),
        "sgu_w": nrm(ks[6], (DEPTH, SGU_GROUPS, CHUNK, CHUNK), CHUNK ** -0.5),
        "sgu_b": gain(ks[7], (DEPTH, SGU_GROUPS, CHUNK)),
        "mix_norm_w": gain(ks[8], (DEPTH, D_MIX)),
        "w_out": nrm(ks[9], (DEPTH, D_MIX, D_MODEL), D_MIX ** -0.5),
        "ln2_w": gain(ks[10], (DEPTH, D_MODEL)),
        "peer_w_query": nrm(ks[11], (DEPTH, D_MODEL, PEER_HEADS * PEER_D_KEY), D_MODEL ** -0.5),
        "peer_keys1": nrm(ks[12], (DEPTH, PEER_HEADS, PEER_KEYS, PEER_D_KEY // 2), (PEER_D_KEY // 2) ** -0.5),
        "peer_keys2": nrm(ks[13], (DEPTH, PEER_HEADS, PEER_KEYS, PEER_D_KEY // 2), (PEER_D_KEY // 2) ** -0.5),
        "peer_u": nrm(ks[14], (DEPTH, PEER_EXPERTS, D_MODEL), D_MODEL ** -0.5),
        "peer_v": nrm(ks[15], (DEPTH, PEER_EXPERTS, D_MODEL), D_MODEL ** -0.5),
        "rel_bias": nrm(ks[16], (NUM_BUCKETS, ATTN_HEADS), 0.1),
    }


def reference(x, ln1_w, w_in, q_norm_w, k_norm_w, sgu_norm_w, sgu_w, sgu_b, mix_norm_w, w_out,
              ln2_w, peer_w_query, peer_keys1, peer_keys2, peer_u, peer_v, rel_bias):
    b, s, _ = x.shape
    for l in range(DEPTH):
        h = _rms(x, ln1_w[l])
        proj = h @ w_in[l]
        q = proj[..., 0:D_ATTN].reshape(b, s, ATTN_HEADS, HEAD_DIM)
        k = proj[..., D_ATTN:2 * D_ATTN].reshape(b, s, ATTN_HEADS, HEAD_DIM)
        v = proj[..., 2 * D_ATTN:3 * D_ATTN].reshape(b, s, ATTN_HEADS, HEAD_DIM)
        ua = jax.nn.gelu(proj[..., 3 * D_ATTN:3 * D_ATTN + D_SGU])
        va = jax.nn.gelu(proj[..., 3 * D_ATTN + D_SGU:])
        q = _rms(q, q_norm_w[l])
        k = _rms(k, k_norm_w[l])
        outs, lses = [], []
        for window, dil in DILATED:
            o_p, lse_p = _dilated_window_attention(q, k, v, rel_bias, window, dil)
            outs.append(o_p)
            lses.append(lse_p)
        wts = jax.nn.softmax(jnp.stack(lses, axis=0), axis=0)
        attn = jnp.sum(wts[..., None] * jnp.stack(outs, axis=0), axis=0)
        attn = attn.astype(x.dtype).reshape(b, s, D_ATTN)
        sgu = _spatial_gating(ua, va, sgu_norm_w[l], sgu_w[l], sgu_b[l])
        mix = jnp.concatenate([_rms(attn, mix_norm_w[l, :D_ATTN]),
                               _rms(sgu, mix_norm_w[l, D_ATTN:])], axis=-1)
        x = x + mix @ w_out[l]
        hn = _rms(x, ln2_w[l])
        x = x + _peer(hn, peer_w_query[l], peer_keys1[l], peer_keys2[l], peer_u[l], peer_v[l])
    return x
```

```cpp
#define MK_HILO 1
#include <hip/hip_runtime.h>
#include <cstdio>
#include <cstdint>
#include <cmath>
namespace pg8 {
#define PG8_LAS __attribute__((address_space(3)))
typedef unsigned short bf16_t;
typedef short bf16x8 __attribute__((ext_vector_type(8)));
typedef float f32x4 __attribute__((ext_vector_type(4)));
typedef unsigned u32x4 __attribute__((ext_vector_type(4)));
constexpr int BM = 256, BK = 64, HALF = 128, HTB = HALF * BK * 2  , STAGE_BYTES = 8 * HTB, NXCD = 8, WGM = 8;

__host__ __device__ __forceinline__ int lds_byte(int r, int c) { const int st = (r >> 4) * 2 + (c >> 5), rr = r & 15, cc = c & 31, ob = rr * 64 + cc * 2; return st * 1024 + (ob ^ (((ob >> 9) & 1) << 5)); }
__host__ __device__ __forceinline__ void stage_rc(int b, int& R, int& C) { const int st = b / 1024, sb = b % 1024, swz = sb ^ (((sb >> 9) & 1) << 5); R = (st >> 1) * 16 + swz / 64; C = (st & 1) * 32 + (swz % 64) / 2; }
__host__ __device__ __forceinline__ int perm32(int rho) { const int n = rho >> 4, i = rho & 15; return 8 * (i >> 2) + 4 * n + (i & 3); }

struct Unit { int pm, pn; };
struct Gemm { const bf16_t* A; const bf16_t* Bt; int M, N, K; };

struct GroupOrder {
    int nM, nN, nwg, G, c;
    __host__ __device__ void init(int M, int N, int G_, int c_) { nM = M / BM; nN = N / BM; nwg = nM * nN; G = G_; c = c_; }
    __host__ __device__ bool next(int i, Unit& u) const { const int L = i * G + c; if (L >= nwg) return false; u.pm = L % nM; u.pn = L / nM; return true; }
    __device__ __forceinline__ void a_ready(const Unit&) const {}
    __device__ __forceinline__ void done(const Unit&) const {}
};
struct StaticOrder {
    int nM, nN, nwg, G, c;
    __host__ __device__ void init(int M, int N, int G_, int c_) { nM = M / BM; nN = N / BM; nwg = nM * nN; G = G_; c = c_; }
    __host__ __device__ bool next(int i, Unit& u) const {
        const long L = (long)i * G + c; if (L >= nwg) return false;
        int wgid = (int)L; { const int q = nwg / NXCD, r = nwg % NXCD, xcd = wgid % NXCD, off = wgid / NXCD; wgid = (xcd < r ? xcd * (q + 1) : r * (q + 1) + (xcd - r) * q) + off; }
        const int nig = WGM * nN, gid = wgid / nig, fm = gid * WGM, gsz = (nM - fm) < WGM ? (nM - fm) : WGM;
        u.pm = fm + ((wgid % nig) % gsz); u.pn = (wgid % nig) / gsz; return true;
    }
    __device__ __forceinline__ void a_ready(const Unit&) const {}
    __device__ __forceinline__ void done(const Unit&) const {}
};


typedef float f32x2_t __attribute__((ext_vector_type(2))); typedef __bf16 bf16x2_t __attribute__((ext_vector_type(2)));
__device__ __forceinline__ unsigned cvtpk(float lo, float hi) { f32x2_t v = {lo, hi}; bf16x2_t b = __builtin_convertvector(v, bf16x2_t); return __builtin_bit_cast(unsigned, b); }
__device__ __forceinline__ float gelu_tanh_f(float x) {
    const float u2 = x * (1.5957691216057308f + 0.07135481627260025f * x * x);
    return x * __builtin_amdgcn_rcpf(1.0f + __builtin_amdgcn_exp2f(-1.4426950408889634f * u2));
}
__device__ __forceinline__ unsigned cvtpk_h(float lo, float hi) { typedef _Float16 h2_t __attribute__((ext_vector_type(2))); f32x2_t v = {lo, hi}; h2_t b = __builtin_convertvector(v, h2_t); return __builtin_bit_cast(unsigned, b); }
constexpr float QSCALE = 0.125f * 1.4426950408889634f;
constexpr float RMS_EPS = 1e-6f;

struct EpiProj {
    static constexpr bool PERM = true, AFTER_DRAIN = false;
    bf16_t *Q, *K, *V, *UA, *VA; const float *qw, *kw;
    __device__ __forceinline__ void operator()(const f32x4 (&acc)[2][2][4][2], const Unit& u, int wr, int wc, int fr, int fq) const {
        const int kind = u.pn >> 1;
        const int cin = (u.pn & 1) * 256 + wc * 64;
        bf16_t* dst = kind == 0 ? Q : kind == 1 ? K : kind == 2 ? V : kind == 3 ? UA : VA;
        f32x4 wv[2][2];
        if (kind < 2) { const float* w = kind == 0 ? qw : kw;
#pragma unroll
            for (int bj = 0; bj < 2; ++bj)
#pragma unroll
                for (int n = 0; n < 2; ++n) wv[bj][n] = *(const f32x4*)(w + 32 * bj + 8 * fq + 4 * n); }
#pragma unroll
        for (int ai = 0; ai < 2; ++ai)
#pragma unroll
            for (int m = 0; m < 4; ++m) {
                const int row = u.pm * BM + ai * HALF + wr * 64 + m * 16 + fr;
                f32x4 v[2][2];
#pragma unroll
                for (int bj = 0; bj < 2; ++bj)
#pragma unroll
                    for (int n = 0; n < 2; ++n) v[bj][n] = acc[ai][bj][m][n];
                if (kind < 2) {
                    float ss = 0.f;
#pragma unroll
                    for (int bj = 0; bj < 2; ++bj)
#pragma unroll
                        for (int n = 0; n < 2; ++n) { const f32x4 x = v[bj][n]; ss += (x[0] * x[0] + x[1] * x[1]) + (x[2] * x[2] + x[3] * x[3]); }
                    ss += __shfl_xor(ss, 16); ss += __shfl_xor(ss, 32);
                    const float r = rsqrtf(ss * (1.0f / 64.0f) + RMS_EPS) * (kind == 0 ? QSCALE : 1.0f);
#pragma unroll
                    for (int bj = 0; bj < 2; ++bj)
#pragma unroll
                        for (int n = 0; n < 2; ++n) v[bj][n] = v[bj][n] * r * wv[bj][n];
                } else if (kind >= 3) {
#pragma unroll
                    for (int bj = 0; bj < 2; ++bj)
#pragma unroll
                        for (int n = 0; n < 2; ++n)
#pragma unroll
                            for (int i = 0; i < 4; ++i) v[bj][n][i] = gelu_tanh_f(v[bj][n][i]);
                }
                bf16_t* rowp = dst + (size_t)row * 512 + cin + 8 * fq;
#pragma unroll
                for (int bj = 0; bj < 2; ++bj) { u32x4 w; w.x = cvtpk(v[bj][0][0], v[bj][0][1]); w.y = cvtpk(v[bj][0][2], v[bj][0][3]); w.z = cvtpk(v[bj][1][0], v[bj][1][1]); w.w = cvtpk(v[bj][1][2], v[bj][1][3]);
                    *(u32x4*)(rowp + 32 * bj) = w; }
            }
    }
};

struct EpiOut {
    static constexpr bool PERM = true, AFTER_DRAIN = false;
    const float* x; float* out; bf16_t* X1B; float* rowsq; bf16_t* loA; bf16_t* loB;
    __device__ __forceinline__ void operator()(const f32x4 (&acc)[2][2][4][2], const Unit& u, int wr, int wc, int fr, int fq) const {
        const int col0 = u.pn * BM + wc * 64 + 8 * fq;
#pragma unroll
        for (int ai = 0; ai < 2; ++ai)
#pragma unroll
            for (int m = 0; m < 4; ++m) {
                const int row = u.pm * BM + ai * HALF + wr * 64 + m * 16 + fr; const size_t off = (size_t)row * 1024 + col0;
                float ss = 0.f;
#pragma unroll
                for (int bj = 0; bj < 2; ++bj) {
                    const f32x4 r0 = *(const f32x4*)(x + off + 32 * bj), r1 = *(const f32x4*)(x + off + 32 * bj + 4);
                    const f32x4 a = acc[ai][bj][m][0] + r0, b = acc[ai][bj][m][1] + r1;
                    ss += (a[0] * a[0] + a[1] * a[1]) + (a[2] * a[2] + a[3] * a[3]) + (b[0] * b[0] + b[1] * b[1]) + (b[2] * b[2] + b[3] * b[3]);
                    u32x4 w; w.x = cvtpk(a[0], a[1]); w.y = cvtpk(a[2], a[3]); w.z = cvtpk(b[0], b[1]); w.w = cvtpk(b[2], b[3]);
                    *(u32x4*)(X1B + off + 32 * bj) = w;
#ifdef MK_HILO
                    u32x4 l;
                    l.x = cvtpk(a[0] - __uint_as_float(w.x << 16), a[1] - __uint_as_float(w.x & 0xffff0000u)); l.y = cvtpk(a[2] - __uint_as_float(w.y << 16), a[3] - __uint_as_float(w.y & 0xffff0000u));
                    l.z = cvtpk(b[0] - __uint_as_float(w.z << 16), b[1] - __uint_as_float(w.z & 0xffff0000u)); l.w = cvtpk(b[2] - __uint_as_float(w.w << 16), b[3] - __uint_as_float(w.w & 0xffff0000u));
                    bf16_t* lop = row < 8192 ? loA + off : loB + (off - (size_t)8192 * 1024);
                    *(u32x4*)(lop + 32 * bj) = l;
#else
                    *(f32x4*)(out + off + 32 * bj) = a; *(f32x4*)(out + off + 32 * bj + 4) = b;
#endif
                }
                ss += __shfl_xor(ss, 16); ss += __shfl_xor(ss, 32);
                if (fq == 0) rowsq[(size_t)row * 16 + u.pn * 4 + wc] = ss;
            }
    }
};

struct EpiPQ {
    static constexpr bool PERM = true, AFTER_DRAIN = false;
    const float* rowsq; bf16_t* PQ;
    __device__ __forceinline__ void operator()(const f32x4 (&acc)[2][2][4][2], const Unit& u, int wr, int wc, int fr, int fq) const {
        const int col0 = u.pn * BM + wc * 64 + 8 * fq;
#pragma unroll
        for (int ai = 0; ai < 2; ++ai)
#pragma unroll
            for (int m = 0; m < 4; ++m) {
                const int row = u.pm * BM + ai * HALF + wr * 64 + m * 16 + fr;
                const f32x4* rq = (const f32x4*)(rowsq + (size_t)row * 16);
                const f32x4 s0 = rq[0], s1 = rq[1], s2 = rq[2], s3 = rq[3];
                const float ss = ((s0[0] + s0[1]) + (s0[2] + s0[3])) + ((s1[0] + s1[1]) + (s1[2] + s1[3])) + ((s2[0] + s2[1]) + (s2[2] + s2[3])) + ((s3[0] + s3[1]) + (s3[2] + s3[3]));
                const float r = rsqrtf(ss * (1.0f / 1024.0f) + RMS_EPS);
                bf16_t* rowp = PQ + (size_t)row * 2048 + col0;
#pragma unroll
                for (int bj = 0; bj < 2; ++bj) { const f32x4 a = acc[ai][bj][m][0] * r, b = acc[ai][bj][m][1] * r;
                    u32x4 w; w.x = cvtpk_h(a[0], a[1]); w.y = cvtpk_h(a[2], a[3]); w.z = cvtpk_h(b[0], b[1]); w.w = cvtpk_h(b[2], b[3]);
                    *(u32x4*)(rowp + 32 * bj) = w; }
            }
    }
};

template <class Epi, class Sched, bool ALIGN_EPI = false, bool SP2 = false>
__device__ __forceinline__ void gemm_phase(PG8_LAS unsigned char* lds, const Gemm g, const Sched& S, const Epi& E) {
    const int tid = threadIdx.x, wid = __builtin_amdgcn_readfirstlane(tid >> 6), lane = tid & 63, wr = wid >> 2, wc = wid & 3, fr = lane & 15, fq = lane >> 4;
    const int K = g.K, nt = K / BK;
    unsigned voffA[2], voffB[2];
#pragma unroll
    for (int i = 0; i < 2; ++i) { int R, C; stage_rc(tid * 16 + i * 8192, R, C); const int Rb = Epi::PERM ? ((R & ~31) + perm32(R & 31)) : R;
        voffA[i] = (unsigned)(R * K + C) * 2u; voffB[i] = (unsigned)(Rb * K + C) * 2u; }
    const size_t kstep = (size_t)(BK * 2);
    const size_t hstep = (size_t)HALF * K * 2;
    const size_t tstep = 2 * hstep;
    const unsigned ldsw = (unsigned)wid * 1024u;
    const int aoff = lds_byte(wr * 64 + fr, fq * 8), boff = lds_byte(wc * 32 + fr, fq * 8);
#define PG8_SA(b, h) (((b) * 2 + (h)) * HTB)
#define PG8_SB(b, h) ((4 + (b) * 2 + (h)) * HTB)
#define PG8_STAGE(bufoff, gbase, voff) do { _Pragma("unroll") for (int _i = 0; _i < 2; ++_i) \
        __builtin_amdgcn_global_load_lds((const unsigned*)((const char*)(gbase) + (voff)[_i]), (PG8_LAS unsigned*)(lds + (bufoff) + ldsw + _i * 8192), 16, 0, 0); } while (0)
#define PG8_LDA(dst, b, h) do { _Pragma("unroll") for (int m = 0; m < 4; ++m) _Pragma("unroll") for (int k = 0; k < 2; ++k) dst[m][k] = *(const PG8_LAS bf16x8*)(lds + PG8_SA(b, h) + aoff + m * 2048 + k * 1024); } while (0)
#define PG8_LDB(dst, b, h) do { _Pragma("unroll") for (int n = 0; n < 2; ++n) _Pragma("unroll") for (int k = 0; k < 2; ++k) dst[n][k] = *(const PG8_LAS bf16x8*)(lds + PG8_SB(b, h) + boff + n * 2048 + k * 1024); } while (0)
#define PG8_MMA(ai, bj, At, Bt) do { __builtin_amdgcn_s_setprio(1); _Pragma("unroll") for (int m = 0; m < 4; ++m) _Pragma("unroll") for (int n = 0; n < 2; ++n) _Pragma("unroll") for (int k = 0; k < 2; ++k) \
        acc[ai][bj][m][n] = __builtin_amdgcn_mfma_f32_16x16x32_bf16(Bt[n][k], At[m][k], acc[ai][bj][m][n], 0, 0, 0); __builtin_amdgcn_s_setprio(0); } while (0)
#define PG8_WAIT_V(n) asm volatile("s_waitcnt vmcnt(" #n ")" ::: "memory")
#define PG8_WAIT_L(n) asm volatile("s_waitcnt lgkmcnt(" #n ")" ::: "memory")
#define PG8_BAR __builtin_amdgcn_s_barrier()
#define PG8_SCHED __builtin_amdgcn_sched_barrier(0)
    Unit cur, nxt; int ui = 0;
    if (!S.next(0, cur)) return;
    f32x4 acc[2][2][4][2];
#pragma unroll
    for (int a = 0; a < 2; ++a)
#pragma unroll
        for (int b = 0; b < 2; ++b)
#pragma unroll
            for (int m = 0; m < 4; ++m)
#pragma unroll
                for (int n = 0; n < 2; ++n) acc[a][b][m][n] = (f32x4){0.f, 0.f, 0.f, 0.f};
    bf16x8 At[4][2], B0[2][2], B1[2][2];
    const char* cA = (const char*)g.A + (size_t)cur.pm * tstep; const char* cB = (const char*)g.Bt + (size_t)cur.pn * tstep;
    S.a_ready(cur);
    if constexpr (SP2) {
        PG8_STAGE(PG8_SB(0, 0), cB, voffB); PG8_STAGE(PG8_SB(0, 1), cB + hstep, voffB); PG8_STAGE(PG8_SA(0, 0), cA, voffA); PG8_STAGE(PG8_SA(0, 1), cA + hstep, voffA);
        if (wr == 1) PG8_BAR;
        PG8_WAIT_V(2); PG8_BAR;
        PG8_STAGE(PG8_SB(1, 0), cB + kstep, voffB); PG8_STAGE(PG8_SA(1, 0), cA + kstep, voffA); PG8_STAGE(PG8_SB(1, 1), cB + hstep + kstep, voffB);
        PG8_WAIT_V(6); PG8_BAR;
    } else {
        PG8_STAGE(PG8_SB(0, 0), cB, voffB); PG8_STAGE(PG8_SA(0, 0), cA, voffA); PG8_STAGE(PG8_SB(0, 1), cB + hstep, voffB); PG8_STAGE(PG8_SA(0, 1), cA + hstep, voffA);
        if (wr == 1) PG8_BAR;
        PG8_WAIT_V(4); PG8_BAR;
        PG8_STAGE(PG8_SB(1, 0), cB + kstep, voffB); PG8_STAGE(PG8_SA(1, 0), cA + kstep, voffA); PG8_STAGE(PG8_SB(1, 1), cB + hstep + kstep, voffB);
        PG8_WAIT_V(6); PG8_BAR;
    }
    for (;;) {
        const bool has_next = S.next(ui + 1, nxt);
        const char* nA = has_next ? (const char*)g.A + (size_t)nxt.pm * tstep : cA; const char* nB = has_next ? (const char*)g.Bt + (size_t)nxt.pn * tstep : cB;
        for (int t = 0; t < nt; t += 2) {
            const bool last = (t == nt - 2);
            const char* a1 = cA + (size_t)(t + 1) * kstep;
            const char* a2 = last ? nA : cA + (size_t)(t + 2) * kstep; const char* b2 = last ? nB : cB + (size_t)(t + 2) * kstep;
            const char* a3 = a2 + kstep; const char* b3 = b2 + kstep;
            if (last && has_next) S.a_ready(nxt);
            if constexpr (SP2) {
            PG8_LDB(B0, 0, 0); PG8_LDB(B1, 0, 1); PG8_SCHED; PG8_LDA(At, 0, 0); PG8_STAGE(PG8_SA(1, 1), a1 + hstep, voffA);
            PG8_WAIT_V(8); PG8_WAIT_L(0); PG8_BAR; PG8_MMA(0, 0, At, B0); PG8_MMA(0, 1, At, B1); PG8_BAR; PG8_SCHED;
            PG8_LDA(At, 0, 1); PG8_STAGE(PG8_SB(0, 0), b2, voffB); PG8_STAGE(PG8_SB(0, 1), b2 + hstep, voffB); PG8_STAGE(PG8_SA(0, 0), a2, voffA);
            PG8_WAIT_V(8); PG8_WAIT_L(0); PG8_BAR; PG8_MMA(1, 0, At, B0); PG8_MMA(1, 1, At, B1); PG8_BAR; PG8_SCHED;
            PG8_LDB(B0, 1, 0); PG8_LDB(B1, 1, 1); PG8_SCHED; PG8_LDA(At, 1, 0); PG8_STAGE(PG8_SA(0, 1), a2 + hstep, voffA);
            PG8_WAIT_V(8); PG8_WAIT_L(0); PG8_BAR; PG8_MMA(0, 0, At, B0); PG8_MMA(0, 1, At, B1); PG8_BAR; PG8_SCHED;
            PG8_LDA(At, 1, 1); PG8_STAGE(PG8_SB(1, 0), b3, voffB); PG8_STAGE(PG8_SB(1, 1), b3 + hstep, voffB); PG8_STAGE(PG8_SA(1, 0), a3, voffA);
            PG8_WAIT_V(8); PG8_WAIT_L(0); PG8_BAR; PG8_MMA(1, 0, At, B0); PG8_MMA(1, 1, At, B1); PG8_BAR; PG8_SCHED;
            } else {
            PG8_LDB(B0, 0, 0); PG8_SCHED; PG8_LDA(At, 0, 0); PG8_STAGE(PG8_SA(1, 1), a1 + hstep, voffA);
            PG8_WAIT_L(8); PG8_BAR; PG8_WAIT_L(0); PG8_MMA(0, 0, At, B0); PG8_BAR; PG8_SCHED;
            PG8_LDB(B1, 0, 1); PG8_STAGE(PG8_SB(0, 0), b2, voffB);
            PG8_BAR; PG8_WAIT_L(0); PG8_MMA(0, 1, At, B1); PG8_BAR;
            PG8_LDA(At, 0, 1); PG8_STAGE(PG8_SA(0, 0), a2, voffA);
            PG8_BAR; PG8_WAIT_L(0); PG8_MMA(1, 0, At, B0); PG8_BAR; PG8_SCHED;
            PG8_STAGE(PG8_SB(0, 1), b2 + hstep, voffB);
            PG8_WAIT_V(6); PG8_BAR; PG8_MMA(1, 1, At, B1); PG8_BAR;
            PG8_LDB(B0, 1, 0); PG8_SCHED; PG8_LDA(At, 1, 0); PG8_STAGE(PG8_SA(0, 1), a2 + hstep, voffA);
            PG8_WAIT_L(8); PG8_BAR; PG8_WAIT_L(0); PG8_MMA(0, 0, At, B0); PG8_BAR; PG8_SCHED;
            PG8_LDB(B1, 1, 1); PG8_STAGE(PG8_SB(1, 0), b3, voffB);
            PG8_BAR; PG8_WAIT_L(0); PG8_MMA(0, 1, At, B1); PG8_BAR;
            PG8_LDA(At, 1, 1); PG8_STAGE(PG8_SA(1, 0), a3, voffA);
            PG8_BAR; PG8_WAIT_L(0); PG8_MMA(1, 0, At, B0); PG8_BAR; PG8_SCHED;
            PG8_STAGE(PG8_SB(1, 1), b3 + hstep, voffB);
            PG8_WAIT_V(6); PG8_BAR; PG8_MMA(1, 1, At, B1); PG8_BAR;
            }
        }
        if constexpr (ALIGN_EPI) { if (wr == 0) PG8_BAR; }
        if constexpr (!Epi::AFTER_DRAIN) { E(acc, cur, wr, wc, fr, fq); S.done(cur); }
        if (!has_next) break;
#pragma unroll
        for (int a = 0; a < 2; ++a)
#pragma unroll
            for (int b = 0; b < 2; ++b)
#pragma unroll
                for (int m = 0; m < 4; ++m)
#pragma unroll
                    for (int n = 0; n < 2; ++n) acc[a][b][m][n] = (f32x4){0.f, 0.f, 0.f, 0.f};
        cur = nxt; cA = nA; cB = nB; ++ui;
        if constexpr (ALIGN_EPI) { if (wr == 1) PG8_BAR; }
    }
    PG8_WAIT_V(0);
    if constexpr (!ALIGN_EPI) { if (wr == 0) PG8_BAR; }
    PG8_BAR;
    if constexpr (Epi::AFTER_DRAIN) { E.fused(acc, cur, wr, wc, fr, fq, lds, wid, lane); S.done(cur); }
#undef PG8_SA
#undef PG8_SB
#undef PG8_STAGE
#undef PG8_LDA
#undef PG8_LDB
#undef PG8_MMA
#undef PG8_WAIT_V
#undef PG8_WAIT_L
#undef PG8_BAR
#undef PG8_SCHED
}
}

constexpr int NWAVES = 8;
constexpr int T = 16384, DM = 1024, SEQ = 2048;
constexpr float EPS = 1e-6f;
constexpr float LOG2E = 1.4426950408889634f;

constexpr size_t MiB = 1u << 20;
constexpr size_t WS_CTL = 0, CTL_ZERO_BYTES = 1 * MiB;
constexpr size_t WS_BIAS = 1 * MiB;
constexpr size_t WS_KEYS = 1 * MiB + 64 * 1024;
constexpr size_t WS_WIN = 2 * MiB, WS_WOUT = 7 * MiB, WS_WQ = 9 * MiB;
constexpr size_t WS_ROWSQ = 13 * MiB;
constexpr size_t WS_U = 16 * MiB, WS_V = 48 * MiB;
constexpr size_t WS_SU = 32 * MiB, WS_SV = 33 * MiB;
constexpr size_t SLAB0 = 64 * MiB, SLAB = 21 * MiB;
constexpr size_t OFF_H = 0;
constexpr size_t OFF_Q = 4 * MiB, OFF_K = 6 * MiB, OFF_VV = 8 * MiB;
constexpr size_t OFF_UA = 10 * MiB, OFF_VA = 12 * MiB;
constexpr size_t OFF_OP = 14 * MiB;
constexpr size_t OFF_LSE = 20 * MiB;
constexpr size_t OFF_X1B = 4 * MiB;
constexpr size_t OFF_LO = 8 * MiB;
constexpr size_t OFF_SC = 12 * MiB;
constexpr size_t WS_SEL = 232 * MiB;
constexpr size_t WS_END = 248 * MiB;
constexpr int CW_BAR = 4096;
constexpr int CW_GRP = 8192, CW_GGEN = 9216, CW_TBL = 10240;

constexpr int RING_OFF = 0, RING_BYTES = 131072;
constexpr int LDSCTL_OFF = RING_BYTES, MISC_OFF = LDSCTL_OFF + 320;
constexpr int LDS_BYTES = 147456;

#define GAS __attribute__((address_space(1)))
#define LAS __attribute__((address_space(3)))
typedef unsigned short bf16;
typedef unsigned v4u __attribute__((ext_vector_type(4)));
typedef unsigned v2u __attribute__((ext_vector_type(2)));
typedef float f32x4 __attribute__((ext_vector_type(4)));
typedef float f32x16 __attribute__((ext_vector_type(16)));
typedef short bf16x8 __attribute__((ext_vector_type(8)));
typedef short s16x4 __attribute__((ext_vector_type(4)));
typedef short v4i16_t __attribute__((ext_vector_type(4)));
typedef __bf16 bf16x2 __attribute__((ext_vector_type(2)));
typedef GAS unsigned gu32;
#define RLX_AGENT __ATOMIC_RELAXED, __HIP_MEMORY_SCOPE_AGENT
#define LDS_WAIT() asm volatile("s_waitcnt lgkmcnt(0)" ::: "memory")
using pg8::cvtpk; using pg8::gelu_tanh_f; using pg8::f32x2_t;
__device__ __forceinline__ float bf_lo(unsigned w) { return __uint_as_float(w << 16); }
__device__ __forceinline__ float bf_hi(unsigned w) { return __uint_as_float(w & 0xffff0000u); }
__device__ __forceinline__ float dot2_bf16(unsigned w, unsigned x, float acc) { return __builtin_amdgcn_fdot2_f32_bf16(__builtin_bit_cast(bf16x2, w), __builtin_bit_cast(bf16x2, x), acc, false); }
template <int CTRL> __device__ __forceinline__ float dpp(float x) { return __builtin_bit_cast(float, __builtin_amdgcn_mov_dpp(__builtin_bit_cast(int, x), CTRL, 0xf, 0xf, true)); }
__device__ __forceinline__ float swap32_other(float x) {
    auto s = __builtin_amdgcn_permlane32_swap(__float_as_uint(x), __float_as_uint(x), false, false);
    return (threadIdx.x & 32) ? __uint_as_float(s[0]) : __uint_as_float(s[1]);
}
__device__ __forceinline__ float row16_sum(float x) {
    x += dpp<0xB1>(x); x += dpp<0x4E>(x); x += dpp<0x141>(x); x += dpp<0x128>(x); return x;
}
__device__ __forceinline__ float wave_sum(float x) {
    x = row16_sum(x);
    auto s = __builtin_amdgcn_permlane16_swap(__float_as_uint(x), __float_as_uint(x), false, false);
    x = __uint_as_float(s[0]) + __uint_as_float(s[1]);
    auto t = __builtin_amdgcn_permlane32_swap(__float_as_uint(x), __float_as_uint(x), false, false);
    return __uint_as_float(t[0]) + __uint_as_float(t[1]);
}
__device__ __forceinline__ s16x4 vtr(const LAS unsigned char* p) { return __builtin_bit_cast(s16x4, __builtin_amdgcn_ds_read_tr16_b64_v4i16((LAS v4i16_t*)p)); }
template <int ROWB> __device__ __forceinline__ unsigned char* sbase(unsigned char* ws, int b, size_t off) { return ws + SLAB0 + (size_t)b * SLAB + off - (size_t)b * 2048 * ROWB; }
template <int ROWB> __device__ __forceinline__ const unsigned char* sbase(const unsigned char* ws, int b, size_t off) { return ws + SLAB0 + (size_t)b * SLAB + off - (size_t)b * 2048 * ROWB; }
__device__ __forceinline__ const bf16* x1lo_ptr(const unsigned char* ws, size_t row) { return (const bf16*)sbase<2048>(ws, (int)(row >> 11), OFF_LO) + row * 1024; }
__device__ __forceinline__ int crow(int r, int hi) { return (r & 3) + 8 * (r >> 2) + 4 * hi; }
#define XB_TMO      128
#define XB_XCNT(j)  (256  + 64 * (j))
#define XB_XSUB(j)  (1280 + 64 * (j))
#define XB_XGEN(j)  (2304 + 64 * (j))
#define XB_TOP      3328
#define XB_TOPGEN   3392
#define XCD_BAR_WORDS 3456
#define XB_SPIN_CAP (1u << 18)

__device__ __forceinline__ unsigned xb_ld(unsigned* p)              { return __hip_atomic_load(p, __ATOMIC_RELAXED, __HIP_MEMORY_SCOPE_AGENT); }
__device__ __forceinline__ unsigned xb_add(unsigned* p, unsigned v) { return __hip_atomic_fetch_add(p, v, __ATOMIC_RELAXED, __HIP_MEMORY_SCOPE_AGENT); }
__device__ __forceinline__ unsigned xb_xcc_id() { return (unsigned)__builtin_amdgcn_s_getreg((3 << 11) | 20) & 0xFu; }
#define XB_SPIN(cond, bar) do { unsigned _sp = 0; while (cond) { __builtin_amdgcn_s_sleep(1); \
    if ((++_sp & 255u) == 0u) { if (xb_ld(&(bar)[XB_TMO])) break; if (_sp > XB_SPIN_CAP) { atomicAdd(&(bar)[XB_TMO], 1u); break; } } } } while (0)

struct XcdBarrier {
    unsigned* bar; unsigned x;
    volatile LAS unsigned* st;
};

__device__ __forceinline__ XcdBarrier xcd_barrier_post(unsigned* bar, volatile LAS unsigned* st) {
    XcdBarrier b; b.bar = bar; b.x = xb_xcc_id(); b.st = st;
    if (threadIdx.x == 0) (void)xb_add(&bar[XB_XCNT(b.x)], 1u);
    return b;
}
__device__ __forceinline__ void xcd_barrier_complete(unsigned* bar, unsigned x, unsigned& nloc, unsigned& nx) {
    const unsigned G = gridDim.x * gridDim.y * gridDim.z;
    unsigned sum, cnt, mine, sp = 0u;
    for (;;) {
        sum = 0u; cnt = 0u; mine = 0u;
#pragma unroll
        for (unsigned j = 0; j < 16; ++j) { const unsigned c = xb_ld(&bar[XB_XCNT(j)]); sum += c; cnt += (c > 0u) ? 1u : 0u; mine = (j == x) ? c : mine; }
        if (sum == G) break;
        __builtin_amdgcn_s_sleep(1);
        if ((++sp & 255u) == 0u) { if (xb_ld(&bar[XB_TMO])) break; if (sp > XB_SPIN_CAP) { atomicAdd(&bar[XB_TMO], 1u); break; } }
    }
    nloc = mine > 0u ? mine : 1u; nx = cnt > 0u ? cnt : 1u;
}

__device__ __forceinline__ void xcd_barrier(const XcdBarrier& b) {
    asm volatile("s_waitcnt vmcnt(0)" ::: "memory");
    __syncthreads();
    if (threadIdx.x == 0) {
        unsigned* bar = b.bar;
        __builtin_amdgcn_s_waitcnt(0);
        unsigned nloc = b.st[0], nx = b.st[1];
        if (nloc == 0u) { xcd_barrier_complete(bar, b.x, nloc, nx); b.st[0] = nloc; b.st[1] = nx; }
        const unsigned old = xb_add(&bar[XB_XSUB(b.x)], 1u);
        const unsigned gen = old / nloc;
        if (old + 1u == (gen + 1u) * nloc) {
            __builtin_amdgcn_fence(__ATOMIC_RELEASE, "agent");
            asm volatile("s_waitcnt vmcnt(0)" ::: "memory");
            const unsigned og = xb_add(&bar[XB_TOP], 1u);
            const unsigned tg = og / nx;
            if (og + 1u == (tg + 1u) * nx) xb_add(&bar[XB_TOPGEN], 1u);
            else XB_SPIN(xb_ld(&bar[XB_TOPGEN]) == tg, bar);
            __builtin_amdgcn_fence(__ATOMIC_ACQUIRE, "agent");
            xb_add(&bar[XB_XGEN(b.x)], 1u);
            asm volatile("s_waitcnt vmcnt(0)" ::: "memory");
        } else {
            XB_SPIN(xb_ld(&bar[XB_XGEN(b.x)]) == gen, bar);
            __builtin_amdgcn_fence(__ATOMIC_ACQUIRE, "agent");
            asm volatile("s_waitcnt vmcnt(0)" ::: "memory");
        }
    }
    __syncthreads();
}

struct Args { const float* in[17]; float* out; unsigned char* ws; int ph_lo, ph_hi; };

__device__ __forceinline__ void p0_transpose_item(const float* W, int K, int N, bf16* WT, LAS float* scr, int item, int lane, const float* kscale) {
    const int nblk = N / 32, kb = item / nblk, nb = item % nblk, k0 = 64 * kb, n0 = 32 * nb;
    const int r0 = (n0 & ~255) + 128 * ((n0 >> 5) & 1) + 32 * ((n0 >> 6) & 3);
#pragma unroll 8
    for (int i = 0; i < 32; ++i) { const int kk = 2 * i + (lane >> 5); float v = W[(size_t)(k0 + kk) * N + n0 + (lane & 31)]; if (kscale) v *= kscale[k0 + kk]; scr[kk * 33 + (lane & 31)] = v; }
    LDS_WAIT(); asm volatile("" ::: "memory");
    const int c = lane & 7;
#pragma unroll
    for (int j = 0; j < 4; ++j) { const int n = (lane >> 3) + 8 * j; const LAS float* s = scr + (8 * c) * 33 + n;
        v4u o; o.x = cvtpk(s[0 * 33], s[1 * 33]); o.y = cvtpk(s[2 * 33], s[3 * 33]); o.z = cvtpk(s[4 * 33], s[5 * 33]); o.w = cvtpk(s[6 * 33], s[7 * 33]);
        *(GAS v4u*)(WT + (size_t)(r0 + n) * K + k0 + 8 * c) = o; }
    LDS_WAIT(); asm volatile("" ::: "memory");
}
__device__ __forceinline__ int t5_bucket(int dist) {
    if (dist < 16) return dist;
    const float v = logf((float)dist / 16.0f) / 4.852030263919617f * 16.0f;
    const int l = 16 + (int)v;
    return l < 31 ? l : 31;
}
__device__ __forceinline__ void p0_tables(const Args& A, int row_lo, int row_hi, int gw, int NGW, int lane) {
    unsigned char* ws = A.ws; const float* ln2 = A.in[10];
    { const float* pu = A.in[14]; const float* pv = A.in[15]; signed char* U8 = (signed char*)(ws + WS_U); unsigned char* V8 = (unsigned char*)(ws + WS_V);
      float* SU = (float*)(ws + WS_SU); float* SV = (float*)(ws + WS_SV);
      f32x4 lw[4];
#pragma unroll
      for (int i = 0; i < 4; ++i) lw[i] = *(const f32x4*)(ln2 + 16 * lane + 4 * i);
      for (int e = row_lo + gw; e < row_hi; e += NGW) {
        const GAS f32x4* ur = (const GAS f32x4*)(pu + (size_t)e * 1024 + 16 * lane); const GAS f32x4* vr = (const GAS f32x4*)(pv + (size_t)e * 1024 + 16 * lane);
        f32x4 u[4], v[4]; float am = 0.f, bm = 0.f;
#pragma unroll
        for (int i = 0; i < 4; ++i) { u[i] = ur[i] * lw[i]; v[i] = vr[i];
            am = fmaxf(am, fmaxf(fmaxf(fabsf(u[i].x), fabsf(u[i].y)), fmaxf(fabsf(u[i].z), fabsf(u[i].w))));
            bm = fmaxf(bm, fmaxf(fmaxf(fabsf(v[i].x), fabsf(v[i].y)), fmaxf(fabsf(v[i].z), fabsf(v[i].w)))); }
#pragma unroll
        for (int o = 1; o < 64; o <<= 1) { am = fmaxf(am, __shfl_xor(am, o)); bm = fmaxf(bm, __shfl_xor(bm, o)); }
        const float ia = am > 0.f ? 127.0f / am : 0.f, ib = bm > 0.f ? 127.0f / bm : 0.f;
        v4u ou, ov;
#pragma unroll
        for (int i = 0; i < 4; ++i) {
            const int q0 = (int)rintf(u[i].x * ia), q1 = (int)rintf(u[i].y * ia), q2 = (int)rintf(u[i].z * ia), q3 = (int)rintf(u[i].w * ia);
            ou[i] = (unsigned)(q0 & 0xff) | ((unsigned)(q1 & 0xff) << 8) | ((unsigned)(q2 & 0xff) << 16) | ((unsigned)(q3 & 0xff) << 24);
            const int r0 = (int)rintf(v[i].x * ib), r1 = (int)rintf(v[i].y * ib), r2 = (int)rintf(v[i].z * ib), r3 = (int)rintf(v[i].w * ib);
            ov[i] = (unsigned)(r0 & 0xff) | ((unsigned)(r1 & 0xff) << 8) | ((unsigned)(r2 & 0xff) << 16) | ((unsigned)(r3 & 0xff) << 24); }
        const size_t dst = ((size_t)(lane >> 3) * 16384 + e) * 128 + (lane & 7) * 16;
        *(GAS v4u*)(U8 + dst) = ou; *(GAS v4u*)(V8 + dst) = ov;
        if (lane == 0) { SU[e] = am > 0.f ? am * (1.0f / 127.0f) : 1.0f; SV[e] = bm * (1.0f / 127.0f); }
      } }
}
constexpr int WF_W = 0, WF_K = 64 * 129 * 4;
__device__ __forceinline__ void p0_wf_unit(const Args& A, LAS unsigned char* lds, int u, int tid, int lane, int w) {
    const float* wq = A.in[11]; const float* ln2 = A.in[10];
    const int kt = u >> 4, hh16 = u & 15, h = hh16 >> 1, half = hh16 & 1, k0 = 64 * kt, c0 = h * 256 + half * 128;
    const float* keys = (half ? A.in[13] : A.in[12]) + (size_t)h * 128 * 128;
    LAS float* Wt = (LAS float*)(lds + WF_W); LAS float* Kt = (LAS float*)(lds + WF_K);
    __syncthreads();
#pragma unroll
    for (int it = 0; it < 16; ++it) { const int i = tid + 512 * it, r = i >> 7, d = i & 127; Wt[r * 129 + d] = wq[(size_t)(k0 + r) * 2048 + c0 + d] * ln2[k0 + r]; }
#pragma unroll
    for (int it = 0; it < 32; ++it) { const int i = tid + 512 * it, r = i >> 7, d = i & 127; Kt[r * 129 + d] = keys[i]; }
    __syncthreads();
    const int mt = w >> 1, nt = w & 1, a = lane & 31, hh = lane >> 5;
    f32x16 acc;
#pragma unroll
    for (int r = 0; r < 16; ++r) acc[r] = 0.f;
    const LAS float* ap = Kt + (32 * mt + a) * 129 + hh; const LAS float* bp = Wt + (32 * nt + a) * 129 + hh;
#pragma unroll 8
    for (int s = 0; s < 64; ++s) acc = __builtin_amdgcn_mfma_f32_32x32x2f32(ap[2 * s], bp[2 * s], acc, 0, 0, 0);
    bf16* WT = (bf16*)(A.ws + WS_WQ);
#pragma unroll
    for (int r = 0; r < 16; ++r) { const int key = 32 * mt + crow(r, hh); const int n = c0 + key;
        const int row = (n & ~255) + 128 * ((n >> 5) & 1) + 32 * ((n >> 6) & 3) + (n & 31);
        WT[(size_t)row * 1024 + k0 + 32 * nt + a] = (bf16)(cvtpk(acc[r], 0.f) & 0xffffu); }
}
__device__ __forceinline__ void p0_prologue(const Args& A, LAS unsigned char* lds, int gw, int NGW, int wave, int lane) {
    unsigned char* ws = A.ws;
    LAS float* scr = (LAS float*)(lds + RING_OFF + wave * 16384);
    const float* w_in = A.in[2]; const float* w_out = A.in[9]; const float* w_q = A.in[11]; const float* ln2 = A.in[10];
    constexpr int I_IN = (1024 / 64) * (2560 / 32), I_OUT = (1024 / 64) * (1024 / 32), I_Q = (1024 / 64) * (2048 / 32);
    for (int it = gw; it < I_IN + I_OUT; it += NGW) {
        int r = it;
        if (r < I_IN) { p0_transpose_item(w_in, 1024, 2560, (bf16*)(ws + WS_WIN), scr, r, lane, nullptr); continue; } r -= I_IN;
        p0_transpose_item(w_out, 1024, 1024, (bf16*)(ws + WS_WOUT), scr, r, lane, nullptr);
    }
    { const float* x = A.in[0]; const float* ln1 = A.in[1];
      f32x4 wv[4];
#pragma unroll
      for (int j = 0; j < 4; ++j) wv[j] = *((const f32x4*)ln1 + lane + 64 * j);
      for (int m = gw; m < T; m += NGW) {
        const GAS f32x4* xr = (const GAS f32x4*)(x + (size_t)m * DM) + lane;
        f32x4 v[4]; float s = 0.f;
#pragma unroll
        for (int j = 0; j < 4; ++j) { v[j] = xr[64 * j]; s += (v[j].x * v[j].x + v[j].y * v[j].y) + (v[j].z * v[j].z + v[j].w * v[j].w); }
        const float r = rsqrtf(wave_sum(s) * (1.f / DM) + EPS);
        GAS v2u* o8 = (GAS v2u*)((bf16*)sbase<2048>(ws, m >> 11, OFF_H) + (size_t)m * DM) + lane;
#pragma unroll
        for (int j = 0; j < 4; ++j) { const f32x4 y = v[j] * r * wv[j]; v2u o; o.x = cvtpk(y.x, y.y); o.y = cvtpk(y.z, y.w); o8[64 * j] = o; }
      } }
    { const float* rb = A.in[16]; float* BT = (float*)(ws + WS_BIAS);
      for (int i = gw * 64 + lane; i < 3 * 8 * 192; i += NGW * 64) {
        const int x = i % 192, h = (i / 192) & 7, p = i / (192 * 8); const int rel = 159 - x; const int dil = p == 0 ? 1 : (p == 1 ? 4 : 16);
        BT[i] = (rel >= 0 && rel <= 128) ? LOG2E * rb[t5_bucket(rel * dil) * 8 + h] : 0.f;
      } }
}

constexpr int AT_K = 0, AT_V = 49152, AT_Q = 98304, AT_BT = 131072 + 1024;
constexpr float NEGBIG = -1e30f;
struct AttnStage { v4u kr[6], vr[6]; };
__device__ __forceinline__ void attn_decode(int au, int& p, int& b, int& h, int& dil, int& res0, int& i0) {
    p = au >> 9; const int idx = au & 511; b = idx >> 6; h = (idx >> 3) & 7; const int sub = idx & 7;
    if (p == 0) { dil = 1; res0 = 0; i0 = sub * 256; } else if (p == 1) { dil = 4; res0 = sub >> 1; i0 = (sub & 1) * 256; } else { dil = 16; res0 = sub * 2; i0 = 0; }
}
__device__ __forceinline__ void attn_issue(const Args& A, int au, int tid, AttnStage& st) {
    unsigned char* ws = A.ws;
    int p, b, h, dil, res0, i0; attn_decode(au, p, b, h, dil, res0, i0);
    const bf16* Kg = (const bf16*)sbase<1024>(ws, b, OFF_K); const bf16* Vg = (const bf16*)sbase<1024>(ws, b, OFF_VV);
    const size_t tokbase = (size_t)b * SEQ; const int c = tid & 7;
#pragma unroll
    for (int it = 0; it < 6; ++it) { const int R = (tid >> 3) + 64 * it; int tok; bool ok;
        if (p < 2) { const int ki = i0 - 128 + R; ok = ki >= 0; tok = res0 + dil * ki; } else { ok = R < 256; tok = res0 + (R >> 7) + 16 * (R & 127); }
        if (ok) { const size_t off = (tokbase + tok) * 512 + h * 64 + c * 8; st.kr[it] = *(const GAS v4u*)(Kg + off); st.vr[it] = *(const GAS v4u*)(Vg + off); } }
}
__device__ __forceinline__ void attn_commit(const Args& A, LAS unsigned char* lds, int au, int tid, const AttnStage& st) {
    int p, b, h, dil, res0, i0; attn_decode(au, p, b, h, dil, res0, i0);
    const int c = tid & 7;
#pragma unroll
    for (int it = 0; it < 6; ++it) { const int R = (tid >> 3) + 64 * it; const bool ok = p < 2 ? (i0 - 128 + R >= 0) : (R < 256);
        if (ok) { *(LAS v4u*)(lds + AT_K + R * 128 + 16 * (c ^ ((R >> 1) & 7))) = st.kr[it];
                  *(LAS v4u*)(lds + AT_V + (c >> 2) * 24576 + (R >> 4) * 1024 + (R & 15) * 64 + (c & 3) * 16) = st.vr[it]; } }
    { const bf16* Qg = (const bf16*)sbase<1024>(A.ws, b, OFF_Q); const size_t tokbase = (size_t)b * SEQ; v4u qr[4];
#pragma unroll
      for (int it = 0; it < 4; ++it) { const int R = (tid >> 3) + 64 * it; const int tok = p < 2 ? res0 + dil * (i0 + R) : res0 + (R >> 7) + 16 * (R & 127);
        qr[it] = *(const GAS v4u*)(Qg + (tokbase + tok) * 512 + h * 64 + c * 8); }
#pragma unroll
      for (int it = 0; it < 4; ++it) { const int R = (tid >> 3) + 64 * it; *(LAS v4u*)(lds + AT_Q + R * 128 + 16 * (c ^ ((R >> 1) & 7))) = qr[it]; } }
    if (tid < 192) ((LAS float*)(lds + AT_BT))[tid] = ((const float*)(A.ws + WS_BIAS))[(p * 8 + h) * 192 + tid];
}
template <int VAR = 0> __device__ __forceinline__ void attn_compute(const Args& A, LAS unsigned char* lds, int au, int tid, int lane, int w) {
    unsigned char* ws = A.ws;
    const int a = lane & 31, hh = lane >> 5;
    int p, b, h, dil, res0, i0; attn_decode(au, p, b, h, dil, res0, i0);
    bf16* OP = (bf16*)sbase<1024>(ws, b, OFF_OP); float* LSE = (float*)sbase<32>(ws, b, OFF_LSE);
    const size_t tokbase = (size_t)b * SEQ;
    int q0, resw, rowoff;
    if (p < 2) { q0 = i0 + 32 * w; resw = res0; rowoff = 0; } else { q0 = 32 * (w & 3); resw = res0 + (w >> 2); rowoff = -128; }
    const int jmin = (4 - (q0 >> 5)) > 0 ? (4 - (q0 >> 5)) : 0;
    const size_t mq = tokbase + resw + (size_t)dil * (q0 + a);
    bf16x8 qf[4];
    { const int Rq = 32 * w + a; const LAS unsigned char* qp = lds + AT_Q + Rq * 128; const int sq = (Rq >> 1) & 7;
#pragma unroll
      for (int s = 0; s < 4; ++s) qf[s] = *(const LAS bf16x8*)(qp + 16 * ((2 * s + hh) ^ sq)); }
    const LAS float* rt = (const LAS float*)(lds + AT_BT) + (31 - a + 4 * hh);
    f32x16 S[5];
#pragma unroll
    for (int j = 0; j < 5; ++j) {
        if (j >= jmin) {
            const int Rk = 32 * (w + j) + rowoff + a;
#pragma unroll
            for (int r = 0; r < 16; ++r) S[j][r] = (VAR & 4) ? (float)(r + j) : rt[32 * j + (r & 3) + 8 * (r >> 2)];
            const LAS unsigned char* kp = lds + AT_K + Rk * 128; const int sw = (Rk >> 1) & 7;
            if (!(VAR & 2))
#pragma unroll
            for (int s = 0; s < 4; ++s) { const bf16x8 kf = *(const LAS bf16x8*)(kp + 16 * ((2 * s + hh) ^ sw)); S[j] = __builtin_amdgcn_mfma_f32_32x32x16_bf16(kf, qf[s], S[j], 0, 0, 0); }
            if (j == 0) {
#pragma unroll
                for (int r = 0; r < 16; ++r) if (crow(r, hh) < a) S[j][r] = NEGBIG;
            }
            if (j == 4) {
#pragma unroll
                for (int r = 0; r < 16; ++r) if (crow(r, hh) > a) S[j][r] = NEGBIG;
            }
        } else {
#pragma unroll
            for (int r = 0; r < 16; ++r) S[j][r] = NEGBIG;
        }
    }
    float mx = NEGBIG;
#pragma unroll
    for (int j = 0; j < 5; ++j)
#pragma unroll
        for (int r = 0; r < 16; ++r) mx = fmaxf(mx, S[j][r]);
    mx = fmaxf(mx, swap32_other(mx));
    float l = 0.f;
#pragma unroll
    for (int j = 0; j < 5; ++j)
#pragma unroll
        for (int r = 0; r < 16; ++r) { const float e = __builtin_amdgcn_exp2f(S[j][r] - mx); S[j][r] = e; l += e; }
    l += swap32_other(l);
    f32x16 o[2];
#pragma unroll
    for (int r = 0; r < 16; ++r) { o[0][r] = 0.f; o[1][r] = 0.f; }
    const LAS unsigned char* vb = lds + AT_V + ((lane >> 4) & 1) * 32 + (lane & 3) * 8 + (4 * hh + ((lane & 15) >> 2)) * 64;
#pragma unroll
    for (int j = 0; j < 5; ++j) {
        if (j >= jmin && !(VAR & 8)) {
            const int G0 = (32 * (w + j) + rowoff) >> 4;
#pragma unroll
            for (int s2 = 0; s2 < 2; ++s2) {
                v4u pw; pw.x = cvtpk(S[j][8 * s2 + 0], S[j][8 * s2 + 1]); pw.y = cvtpk(S[j][8 * s2 + 2], S[j][8 * s2 + 3]); pw.z = cvtpk(S[j][8 * s2 + 4], S[j][8 * s2 + 5]); pw.w = cvtpk(S[j][8 * s2 + 6], S[j][8 * s2 + 7]);
                const bf16x8 pf = __builtin_bit_cast(bf16x8, pw);
#pragma unroll
                for (int d0 = 0; d0 < 2; ++d0) {
                    const LAS unsigned char* vp = vb + d0 * 24576 + (G0 + s2) * 1024;
                    const s16x4 lo = vtr(vp), hi = vtr(vp + 512);
                    const bf16x8 vf = (bf16x8){lo[0], lo[1], lo[2], lo[3], hi[0], hi[1], hi[2], hi[3]};
                    o[d0] = __builtin_amdgcn_mfma_f32_32x32x16_bf16(vf, pf, o[d0], 0, 0, 0);
                }
            }
        }
    }
    const float inv = __builtin_amdgcn_rcpf(l);
    if (!(VAR & 16))
    { const int Rq = 32 * w + a; LAS unsigned char* op_ = lds + AT_Q + Rq * 128 + 8 * hh; const int sq = (Rq >> 1) & 7;
#pragma unroll
      for (int d0 = 0; d0 < 2; ++d0)
#pragma unroll
        for (int g4 = 0; g4 < 4; ++g4) { v2u ov; ov.x = cvtpk(o[d0][4 * g4 + 0] * inv, o[d0][4 * g4 + 1] * inv); ov.y = cvtpk(o[d0][4 * g4 + 2] * inv, o[d0][4 * g4 + 3] * inv);
            *(LAS v2u*)(op_ + 16 * ((4 * d0 + g4) ^ sq)) = ov; }
      asm volatile("s_waitcnt lgkmcnt(0)" ::: "memory");
#pragma unroll
      for (int it = 0; it < 4; ++it) { const int rr = (lane >> 3) + 8 * it, ch = lane & 7, Rr = 32 * w + rr;
        const v4u v = *(const LAS v4u*)(lds + AT_Q + Rr * 128 + 16 * (ch ^ ((Rr >> 1) & 7)));
        const size_t mrow = tokbase + resw + (size_t)dil * (q0 + rr);
        *(GAS v4u*)(OP + ((size_t)p * SEQ + mrow) * 512 + h * 64 + ch * 8) = v; } }
    if (hh == 0 && (!(VAR & 16) || l == 12345.f)) LSE[((size_t)p * SEQ + mq) * 8 + h] = mx + __builtin_amdgcn_logf(l) + ((VAR & 8) ? o[0][0] + o[1][5] : 0.f);
}

constexpr int SG_IMG = 0, SG_RSTD = 32768;
__device__ __forceinline__ void sgu_unit(const Args& A, LAS unsigned char* lds, int su, int tid, int lane, int w) {
    unsigned char* ws = A.ws;
    bf16* UA = (bf16*)sbase<1024>(ws, su >> 6, OFF_UA); const bf16* VA = (const bf16*)sbase<1024>(ws, su >> 6, OFF_VA);
    const float* nw = A.in[5]; const float* sw = A.in[6]; const float* sb = A.in[7];
    const int a = lane & 31, hh = lane >> 5;
    const int b = su >> 6, n = (su >> 2) & 15, g = su & 3; const size_t m0 = (size_t)b * SEQ + n * 128;
    { const int ch = tid & 15;
#pragma unroll
      for (int it = 0; it < 4; ++it) { const int s = (tid >> 4) + 32 * it;
        const v4u v = *(const GAS v4u*)(VA + (m0 + s) * 512 + g * 128 + ch * 8);
        float ss = 0.f;
#pragma unroll
        for (int i = 0; i < 4; ++i) { const float x0 = bf_lo(v[i]), x1 = bf_hi(v[i]); ss += x0 * x0 + x1 * x1; }
        ss = row16_sum(ss);
        *(LAS v4u*)(lds + SG_IMG + (ch >> 2) * 8192 + (s >> 4) * 1024 + (s & 15) * 64 + (ch & 3) * 16) = v;
        if (ch == 0) ((LAS float*)(lds + SG_RSTD))[s] = rsqrtf(ss * (1.0f / 128.0f) + EPS); } }
    __syncthreads();
    const int tt = w >> 1, t = 32 * tt + a;
    f32x16 acc[2];
#pragma unroll
    for (int r = 0; r < 16; ++r) { acc[0][r] = 0.f; acc[1][r] = 0.f; }
    const float* wrow = sw + ((size_t)(g * 128 + t)) * 128;
    const LAS unsigned char* vb = lds + SG_IMG + ((lane >> 4) & 1) * 32 + (lane & 3) * 8 + (4 * hh + ((lane & 15) >> 2)) * 64;
#pragma unroll
    for (int st = 0; st < 8; ++st) {
        if (st < 2 * tt + 2) {
            const int s0 = 16 * st + 4 * hh;
            const f32x4 w0 = *(const f32x4*)(wrow + s0), w1 = *(const f32x4*)(wrow + s0 + 8);
            const f32x4 r0 = *(const LAS f32x4*)(lds + SG_RSTD + 4 * s0), r1 = *(const LAS f32x4*)(lds + SG_RSTD + 4 * (s0 + 8));
            float e[8];
#pragma unroll
            for (int i = 0; i < 4; ++i) { e[i] = (s0 + i <= t) ? w0[i] * r0[i] : 0.f; e[4 + i] = (s0 + 8 + i <= t) ? w1[i] * r1[i] : 0.f; }
            v4u bw; bw.x = cvtpk(e[0], e[1]); bw.y = cvtpk(e[2], e[3]); bw.z = cvtpk(e[4], e[5]); bw.w = cvtpk(e[6], e[7]);
            const bf16x8 bfr = __builtin_bit_cast(bf16x8, bw);
#pragma unroll
            for (int cbi = 0; cbi < 2; ++cbi) { const int cb = 2 * (w & 1) + cbi;
                const LAS unsigned char* vp = vb + cb * 8192 + st * 1024;
                const s16x4 lo = vtr(vp), hi = vtr(vp + 512);
                const bf16x8 vf = (bf16x8){lo[0], lo[1], lo[2], lo[3], hi[0], hi[1], hi[2], hi[3]};
                acc[cbi] = __builtin_amdgcn_mfma_f32_32x32x16_bf16(vf, bfr, acc[cbi], 0, 0, 0); }
        }
    }
    const float bias = sb[g * 128 + t];
    bf16* urow = UA + (m0 + t) * 512 + g * 128;
#pragma unroll
    for (int cbi = 0; cbi < 2; ++cbi)
#pragma unroll
        for (int g4 = 0; g4 < 4; ++g4) { const int c0 = 32 * (2 * (w & 1) + cbi) + 8 * g4 + 4 * hh;
            const v2u uu = *(const GAS v2u*)(urow + c0); const f32x4 nv = *(const f32x4*)(nw + g * 128 + c0);
            const float y0 = bf_lo(uu.x) * (nv[0] * acc[cbi][4 * g4 + 0] + bias), y1 = bf_hi(uu.x) * (nv[1] * acc[cbi][4 * g4 + 1] + bias);
            const float y2 = bf_lo(uu.y) * (nv[2] * acc[cbi][4 * g4 + 2] + bias), y3 = bf_hi(uu.y) * (nv[3] * acc[cbi][4 * g4 + 3] + bias);
            v2u ov; ov.x = cvtpk(y0, y1); ov.y = cvtpk(y2, y3); *(GAS v2u*)(urow + c0) = ov; }
    __syncthreads();
}

__device__ __forceinline__ void p3_merge(const Args& A, int b, int gw, int NGW, int lane) {
    unsigned char* ws = A.ws;
    const bf16* OP = (const bf16*)sbase<1024>(ws, b, OFF_OP); const float* LSE = (const float*)sbase<32>(ws, b, OFF_LSE); const bf16* SG = (const bf16*)sbase<1024>(ws, b, OFF_UA); bf16* MIX = (bf16*)sbase<2048>(ws, b, OFF_H);
    const float* mw = A.in[8];
    const f32x4 wa0 = *(const f32x4*)(mw + 8 * lane), wa1 = *(const f32x4*)(mw + 8 * lane + 4), ws0 = *(const f32x4*)(mw + 512 + 8 * lane), ws1 = *(const f32x4*)(mw + 512 + 8 * lane + 4);
    for (int m = b * SEQ + gw; m < (b + 1) * SEQ; m += NGW) {
        const int h = lane >> 3;
        const float l0 = LSE[((size_t)0 * SEQ + m) * 8 + h], l1 = LSE[((size_t)1 * SEQ + m) * 8 + h], l2 = LSE[((size_t)2 * SEQ + m) * 8 + h];
        const v4u o0 = *(const GAS v4u*)(OP + ((size_t)0 * SEQ + m) * 512 + 8 * lane), o1 = *(const GAS v4u*)(OP + ((size_t)1 * SEQ + m) * 512 + 8 * lane), o2 = *(const GAS v4u*)(OP + ((size_t)2 * SEQ + m) * 512 + 8 * lane);
        const v4u sg = *(const GAS v4u*)(SG + (size_t)m * 512 + 8 * lane);
        const float mxl = fmaxf(l0, fmaxf(l1, l2));
        float e0 = __builtin_amdgcn_exp2f(l0 - mxl), e1 = __builtin_amdgcn_exp2f(l1 - mxl), e2 = __builtin_amdgcn_exp2f(l2 - mxl);
        const float inv = __builtin_amdgcn_rcpf(e0 + e1 + e2); e0 *= inv; e1 *= inv; e2 *= inv;
        float at[8], sv[8]; float ssa = 0.f, sss = 0.f;
#pragma unroll
        for (int i = 0; i < 4; ++i) {
            at[2 * i] = e0 * bf_lo(o0[i]) + e1 * bf_lo(o1[i]) + e2 * bf_lo(o2[i]); at[2 * i + 1] = e0 * bf_hi(o0[i]) + e1 * bf_hi(o1[i]) + e2 * bf_hi(o2[i]);
            sv[2 * i] = bf_lo(sg[i]); sv[2 * i + 1] = bf_hi(sg[i]);
            ssa += at[2 * i] * at[2 * i] + at[2 * i + 1] * at[2 * i + 1]; sss += sv[2 * i] * sv[2 * i] + sv[2 * i + 1] * sv[2 * i + 1];
        }
        const float ra = rsqrtf(wave_sum(ssa) * (1.0f / 512.0f) + EPS), rs = rsqrtf(wave_sum(sss) * (1.0f / 512.0f) + EPS);
        v4u oa, os;
        oa.x = cvtpk(at[0] * ra * wa0[0], at[1] * ra * wa0[1]); oa.y = cvtpk(at[2] * ra * wa0[2], at[3] * ra * wa0[3]); oa.z = cvtpk(at[4] * ra * wa1[0], at[5] * ra * wa1[1]); oa.w = cvtpk(at[6] * ra * wa1[2], at[7] * ra * wa1[3]);
        os.x = cvtpk(sv[0] * rs * ws0[0], sv[1] * rs * ws0[1]); os.y = cvtpk(sv[2] * rs * ws0[2], sv[3] * rs * ws0[3]); os.z = cvtpk(sv[4] * rs * ws1[0], sv[5] * rs * ws1[1]); os.w = cvtpk(sv[6] * rs * ws1[2], sv[7] * rs * ws1[3]);
        *(GAS v4u*)(MIX + (size_t)m * 1024 + 8 * lane) = oa; *(GAS v4u*)(MIX + (size_t)m * 1024 + 512 + 8 * lane) = os;
    }
}
#ifndef MK_TBL_PRE_PER_GROUP
#define MK_TBL_PRE_PER_GROUP 256
#endif
constexpr int TBL_PRE_PER_GROUP = MK_TBL_PRE_PER_GROUP;
#ifndef MK_DUP
#define MK_DUP 0
#endif

__device__ __forceinline__ int f2key(unsigned bits) { const int s = (int)bits; return s ^ ((s >> 31) & 0x7fffffff); }
__device__ __forceinline__ int imax(int a, int b) { return a > b ? a : b; }
__device__ __forceinline__ int imin(int a, int b) { return a < b ? a : b; }
template <int OFF> __device__ __forceinline__ void sort16_desc(int (&v)[64]) {
#pragma unroll
    for (int k = 2; k <= 16; k <<= 1)
#pragma unroll
        for (int j = k >> 1; j > 0; j >>= 1)
#pragma unroll
            for (int i = 0; i < 16; ++i) { const int l = i ^ j;
                if (l > i) { const int x = v[OFF + i], y = v[OFF + l]; const int hi = imax(x, y), lo = imin(x, y);
                    if ((i & k) == 0) { v[OFF + i] = hi; v[OFF + l] = lo; } else { v[OFF + i] = lo; v[OFF + l] = hi; } } }
}
template <int OFF> __device__ __forceinline__ void bitonic_merge16_desc(int (&v)[64]) {
#pragma unroll
    for (int j = 8; j > 0; j >>= 1)
#pragma unroll
        for (int i = 0; i < 16; ++i) { const int l = i ^ j;
            if (l > i) { const int x = v[OFF + i], y = v[OFF + l]; v[OFF + i] = imax(x, y); v[OFF + l] = imin(x, y); } }
}
template <int A_, int B_> __device__ __forceinline__ void merge_top16(int (&v)[64]) {
#pragma unroll
    for (int i = 0; i < 16; ++i) v[A_ + i] = imax(v[A_ + i], v[B_ + 15 - i]);
    bitonic_merge16_desc<A_>(v);
}
__device__ __forceinline__ void top16_of_64(int (&v)[64]) {
    sort16_desc<0>(v); sort16_desc<16>(v); sort16_desc<32>(v); sort16_desc<48>(v);
    merge_top16<0, 16>(v); merge_top16<32, 48>(v); merge_top16<0, 32>(v);
}
__host__ __device__ constexpr int hyp_off(int i) { int o = 0; for (int k = 0; k < i; ++k) o += 16 / (k + 1); return o; }
static_assert(hyp_off(16) == 50, "50 candidates");
__device__ __forceinline__ int swap32_other_i(int x) {
    auto s = __builtin_amdgcn_permlane32_swap((unsigned)x, (unsigned)x, false, false);
    return (threadIdx.x & 32) ? (int)s[0] : (int)s[1];
}

__device__ __forceinline__ void route_tile(const Args& A, LAS unsigned char* stg, LAS unsigned char* kl8, LAS unsigned short* idxL, LAS float* gateL, size_t m0, int tl0, int h, int lane) {
    unsigned char* ws = A.ws;
    const unsigned short* SC = (const unsigned short*)sbase<4096>(ws, (int)(m0 >> 11), OFF_SC);
    const int a = lane & 31, hh = lane >> 5;
    int top[2][16];
#pragma unroll
    for (int half = 0; half < 2; ++half) {
        v4u sr[8];
#pragma unroll
        for (int it = 0; it < 8; ++it) sr[it] = *(const GAS v4u*)(SC + (m0 + (lane >> 4) + 4 * it) * 2048 + h * 256 + half * 128 + (lane & 15) * 8);
#pragma unroll
        for (int it = 0; it < 8; ++it) { const int row = (lane >> 4) + 4 * it; *(LAS v4u*)(stg + row * 256 + 16 * ((lane & 15) ^ (row & 15))) = sr[it]; }
        asm volatile("s_waitcnt lgkmcnt(0)" ::: "memory");
        int v[64];
#pragma unroll
        for (int j = 0; j < 8; ++j) { const v4u d = *(const LAS v4u*)(stg + a * 256 + 16 * ((8 * hh + j) ^ (a & 15)));
#pragma unroll
            for (int i = 0; i < 4; ++i) { const unsigned key = 64 * hh + 8 * j + 2 * i;
                const float f0 = (float)__builtin_bit_cast(_Float16, (unsigned short)(d[i] & 0xffffu)), f1 = (float)__builtin_bit_cast(_Float16, (unsigned short)(d[i] >> 16));
                v[8 * j + 2 * i] = f2key((__float_as_uint(f0) & 0xffffff80u) | key); v[8 * j + 2 * i + 1] = f2key((__float_as_uint(f1) & 0xffffff80u) | (key + 1)); } }
        asm volatile("s_waitcnt lgkmcnt(0)" ::: "memory");
        top16_of_64(v);
#pragma unroll
        for (int i = 0; i < 16; ++i) v[16 + i] = swap32_other_i(v[i]);
        merge_top16<0, 16>(v);
#pragma unroll
        for (int i = 0; i < 16; ++i) top[half][i] = f2key((unsigned)v[i]);
    }
    LAS unsigned char* kl = kl8 + lane;
#pragma unroll
    for (int i = 0; i < 16; ++i) { kl[64 * i] = (unsigned char)((unsigned)top[0][i] & 0x7fu); kl[64 * (16 + i)] = (unsigned char)((unsigned)top[1][i] & 0x7fu); }
    int v[64];
#pragma unroll
    for (int i = 0; i < 64; ++i) v[i] = f2key(0xff800000u);
#pragma unroll
    for (int i = 0; i < 16; ++i)
#pragma unroll
        for (int j = 0; j < 16; ++j)
            if ((i + 1) * (j + 1) <= 16) {
                const float s = __uint_as_float((unsigned)top[0][i] & 0xffffff80u) + __uint_as_float((unsigned)top[1][j] & 0xffffff80u);
                v[hyp_off(i) + j] = f2key((__float_as_uint(s) & 0xffffff00u) | (unsigned)(i * 16 + j));
            }
    top16_of_64(v);
    float g[16]; float den = 0.f; const float b0 = __uint_as_float((unsigned)f2key((unsigned)v[0]) & 0xffffff00u);
#pragma unroll
    for (int r = 0; r < 16; ++r) { g[r] = __builtin_amdgcn_exp2f((__uint_as_float((unsigned)f2key((unsigned)v[r]) & 0xffffff00u) - b0) * LOG2E); den += g[r]; }
    const float inv = __builtin_amdgcn_rcpf(den);
#pragma unroll
    for (int r = 0; r < 16; ++r) {
        if ((r >> 3) == hh) {
            const unsigned ij = (unsigned)f2key((unsigned)v[r]) & 0xffu;
            const unsigned e = (unsigned)kl[64 * (ij >> 4)] * 128u + (unsigned)kl[64 * (16 + (ij & 15u))];
            idxL[((tl0 + a) * 16 + r) * 8 + h] = (unsigned short)e; gateL[((tl0 + a) * 16 + r) * 8 + h] = g[r] * inv;
#ifdef MK_WRITE_SEL
            { v2u o; o.x = e; o.y = __float_as_uint(g[r] * inv); *(GAS v2u*)((v2u*)(ws + WS_SEL) + (m0 + a) * 128 + h * 16 + r) = o; }
#endif
        }
    }
    asm volatile("s_waitcnt lgkmcnt(0)" ::: "memory");
}

constexpr size_t P7_SLICE_ELEMS = (size_t)16384 * 64;
template <int PMODE = 0> __device__ __forceinline__ void p7_sliced(const Args& A, LAS unsigned char* lds, int vcu, int lane, int w, float* out, const XcdBarrier& bar) {
    unsigned char* ws = A.ws;
    const bf16* U = (const bf16*)(ws + WS_U); const bf16* V = (const bf16*)(ws + WS_V); const bf16* X1B = (const bf16*)sbase<2048>(ws, vcu >> 5, OFF_X1B);
    const float* rowsq = (const float*)(ws + WS_ROWSQ);
    const int g = lane >> 2, c = lane & 3;
    const size_t mbase = (size_t)vcu * 64 + w * 8;
    { LAS unsigned char* stg_ = lds + 49152 + w * 8192; LAS unsigned char* kl8_ = lds + 114688 + w * 2048;
      route_tile(A, stg_, kl8_, (LAS unsigned short*)lds, (LAS float*)(lds + 16384), (size_t)vcu * 64 + 32 * (w & 1), 32 * (w & 1), w >> 1, lane);
      route_tile(A, stg_, kl8_, (LAS unsigned short*)lds, (LAS float*)(lds + 16384), (size_t)vcu * 64 + 32 * (w & 1), 32 * (w & 1), (w >> 1) + 4, lane); }
    __syncthreads();
    LAS unsigned short* idxL = (LAS unsigned short*)(lds + w * 2048);
    LAS float* gateL = (LAS float*)(lds + 16384 + w * 4096);
    float rs[8];
#pragma unroll
    for (int tk = 0; tk < 8; ++tk) rs[tk] = rsqrtf(row16_sum(rowsq[(mbase + tk) * 16 + (lane & 15)]) * (1.0f / 1024.0f) + EPS);
    LAS signed char* x8 = (LAS signed char*)(lds + 49152 + w * 8192);
    float sxs[8];
#pragma unroll
    for (int tk = 0; tk < 8; ++tk) {
        const bf16* xr = X1B + (mbase + tk) * 1024 + 16 * lane;
        const v4u x0 = *(const GAS v4u*)xr, x1 = *(const GAS v4u*)(xr + 8);
        float f[16]; float am = 0.f;
#pragma unroll
        for (int i = 0; i < 4; ++i) { f[2 * i] = bf_lo(x0[i]); f[2 * i + 1] = bf_hi(x0[i]); f[8 + 2 * i] = bf_lo(x1[i]); f[8 + 2 * i + 1] = bf_hi(x1[i]); }
#pragma unroll
        for (int i = 0; i < 16; ++i) am = fmaxf(am, fabsf(f[i]));
#pragma unroll
        for (int o = 1; o < 64; o <<= 1) am = fmaxf(am, __shfl_xor(am, o));
        const float inv = am > 0.f ? 127.0f / am : 0.f;
        v4u o;
#pragma unroll
        for (int i = 0; i < 4; ++i) { const int q0 = (int)rintf(f[4 * i] * inv), q1 = (int)rintf(f[4 * i + 1] * inv), q2 = (int)rintf(f[4 * i + 2] * inv), q3 = (int)rintf(f[4 * i + 3] * inv);
            o[i] = (unsigned)(q0 & 0xff) | ((unsigned)(q1 & 0xff) << 8) | ((unsigned)(q2 & 0xff) << 16) | ((unsigned)(q3 & 0xff) << 24); }
        *(LAS v4u*)(x8 + tk * 1024 + 16 * lane) = o;
        sxs[tk] = am * (1.0f / 127.0f) * rs[tk];
    }
    int acc[8][8];
#pragma unroll
    for (int tk = 0; tk < 8; ++tk)
#pragma unroll
        for (int q = 0; q < 8; ++q) acc[tk][q] = 0;
    const signed char* Uc = (const signed char*)(ws + WS_U) + 16 * c;
#define P7A_ISSUE(BUF, jj, s_) do { \
        const signed char* Uj_ = Uc + (size_t)(jj) * ((size_t)16384 * 128); \
        const unsigned idw_ = *(const LAS unsigned*)(idxL + (((s_) >> 2) * 16 + g) * 8 + 2 * ((s_) & 3)); \
        const signed char* up0_ = Uj_ + (size_t)(idw_ & 0xffffu) * 128; const signed char* up1_ = Uj_ + (size_t)(idw_ >> 16) * 128; \
        BUF[0] = *(const GAS v4u*)up0_; BUF[1] = *(const GAS v4u*)(up0_ + 64); BUF[2] = *(const GAS v4u*)up1_; BUF[3] = *(const GAS v4u*)(up1_ + 64); } while (0)
#define P7A_MATH(BUF, XA, XB, s_) do { \
        _Pragma("unroll") for (int qq_ = 0; qq_ < 2; ++qq_) { int d_ = acc[(s_) >> 2][2 * ((s_) & 3) + qq_]; \
            _Pragma("unroll") for (int i_ = 0; i_ < 4; ++i_) { d_ = __builtin_amdgcn_sdot4((int)BUF[2 * qq_][i_], (int)XA[i_], d_, false); d_ = __builtin_amdgcn_sdot4((int)BUF[2 * qq_ + 1][i_], (int)XB[i_], d_, false); } \
            acc[(s_) >> 2][2 * ((s_) & 3) + qq_] = d_; } } while (0)
    {
        v4u b0[4], b1[4], b2[4], b3[4];
        if (!(PMODE & 2)) { P7A_ISSUE(b0, 0, 0); P7A_ISSUE(b1, 0, 1); P7A_ISSUE(b2, 0, 2); }
        for (int j = 0; j < ((PMODE & 2) ? 0 : 8); ++j) {
            const int jn = j < 7 ? j + 1 : 7;
#ifdef MK_P7_RESYNC
            if (PMODE == 0 && (j & (MK_P7_RESYNC - 1)) == 0 && j) xcd_barrier(bar);
#endif
#pragma unroll
            for (int tk = 0; tk < 8; ++tk) {
                const v4u xa = *(const LAS v4u*)(x8 + tk * 1024 + 128 * j + 16 * c), xb = *(const LAS v4u*)(x8 + tk * 1024 + 128 * j + 64 + 16 * c);
                P7A_ISSUE(b3, j, 4 * tk + 3); __builtin_amdgcn_sched_barrier(0);
                P7A_MATH(b0, xa, xb, 4 * tk + 0); __builtin_amdgcn_sched_barrier(0);
                if (tk < 7) P7A_ISSUE(b0, j, 4 * tk + 4); else P7A_ISSUE(b0, jn, 0);
                __builtin_amdgcn_sched_barrier(0);
                P7A_MATH(b1, xa, xb, 4 * tk + 1); __builtin_amdgcn_sched_barrier(0);
                if (tk < 7) P7A_ISSUE(b1, j, 4 * tk + 5); else P7A_ISSUE(b1, jn, 1);
                __builtin_amdgcn_sched_barrier(0);
                P7A_MATH(b2, xa, xb, 4 * tk + 2); __builtin_amdgcn_sched_barrier(0);
                if (tk < 7) P7A_ISSUE(b2, j, 4 * tk + 6); else P7A_ISSUE(b2, jn, 2);
                __builtin_amdgcn_sched_barrier(0);
                P7A_MATH(b3, xa, xb, 4 * tk + 3); __builtin_amdgcn_sched_barrier(0);
            }
        }
    }
#undef P7A_ISSUE
#undef P7A_MATH
    const float* SU = (const float*)(ws + WS_SU); const float* SV = (const float*)(ws + WS_SV);
    unsigned w4[8][2]; float sw[8];
#pragma unroll
    for (int tk = 0; tk < 8; ++tk) {
        const LAS f32x4* gp = (const LAS f32x4*)(gateL + (tk * 16 + g) * 8); const f32x4 g0 = gp[0], g1 = gp[1];
        const v4u id = *(const LAS v4u*)(idxL + (tk * 16 + g) * 8);
        float wq[8];
#pragma unroll
        for (int q = 0; q < 8; ++q) { int s = acc[tk][q]; s += __builtin_amdgcn_mov_dpp(s, 0xB1, 0xf, 0xf, true); s += __builtin_amdgcn_mov_dpp(s, 0x4E, 0xf, 0xf, true);
            const unsigned e = (id[q >> 1] >> (16 * (q & 1))) & 0xffffu;
            wq[q] = (q < 4 ? g0[q & 3] : g1[q & 3]) * gelu_tanh_f(sxs[tk] * SU[e] * (float)s) * SV[e]; }
        float am = 0.f;
#pragma unroll
        for (int q = 0; q < 8; ++q) am = fmaxf(am, fabsf(wq[q]));
#pragma unroll
        for (int o = 1; o < 64; o <<= 1) am = fmaxf(am, __shfl_xor(am, o));
        const float inv = am > 0.f ? 127.0f / am : 0.f; sw[tk] = am * (1.0f / 127.0f);
#pragma unroll
        for (int k = 0; k < 2; ++k) { const int q0 = (int)rintf(wq[4 * k] * inv), q1 = (int)rintf(wq[4 * k + 1] * inv), q2 = (int)rintf(wq[4 * k + 2] * inv), q3 = (int)rintf(wq[4 * k + 3] * inv);
            w4[tk][k] = (unsigned)(q0 & 0xff) | ((unsigned)(q1 & 0xff) << 8) | ((unsigned)(q2 & 0xff) << 16) | ((unsigned)(q3 & 0xff) << 24); }
    }
    const signed char* Vc = (const signed char*)(ws + WS_V) + 16 * c;
#define P7B_ISSUE(BUF, jj, s_) do { \
        const signed char* Vj_ = Vc + (size_t)(jj) * ((size_t)16384 * 128); \
        const v2u id_ = *(const LAS v2u*)(idxL + (((s_) >> 1) * 16 + g) * 8 + 4 * ((s_) & 1)); \
        _Pragma("unroll") for (int qq_ = 0; qq_ < 4; ++qq_) { const unsigned e_ = (id_[qq_ >> 1] >> (16 * (qq_ & 1))) & 0xffffu; const signed char* vp_ = Vj_ + (size_t)e_ * 128; \
            BUF[2 * qq_] = *(const GAS v4u*)vp_; BUF[2 * qq_ + 1] = *(const GAS v4u*)(vp_ + 64); } } while (0)
#define P7B_MATH(BUF, s_) do { const int wq_ = (int)w4[(s_) >> 1][(s_) & 1]; if (PMODE & 8) { y[(s_) & 31] += (int)(BUF[0][0] ^ BUF[1][1] ^ BUF[2][2] ^ BUF[3][3] ^ BUF[4][0] ^ BUF[5][1] ^ BUF[6][2] ^ BUF[7][3]) & wq_; } else \
        _Pragma("unroll") for (int ch_ = 0; ch_ < 2; ++ch_) \
        _Pragma("unroll") for (int i_ = 0; i_ < 4; ++i_) { const unsigned a_ = BUF[0 + ch_][i_], b_ = BUF[2 + ch_][i_], c_ = BUF[4 + ch_][i_], d_ = BUF[6 + ch_][i_]; \
            const unsigned pl_ = __builtin_amdgcn_perm(b_, a_, 0x05010400u), ph_ = __builtin_amdgcn_perm(b_, a_, 0x07030602u), ql_ = __builtin_amdgcn_perm(d_, c_, 0x05010400u), qh_ = __builtin_amdgcn_perm(d_, c_, 0x07030602u); \
            y[16 * ch_ + 4 * i_ + 0] = __builtin_amdgcn_sdot4((int)__builtin_amdgcn_perm(ql_, pl_, 0x05040100u), wq_, y[16 * ch_ + 4 * i_ + 0], false); \
            y[16 * ch_ + 4 * i_ + 1] = __builtin_amdgcn_sdot4((int)__builtin_amdgcn_perm(ql_, pl_, 0x07060302u), wq_, y[16 * ch_ + 4 * i_ + 1], false); \
            y[16 * ch_ + 4 * i_ + 2] = __builtin_amdgcn_sdot4((int)__builtin_amdgcn_perm(qh_, ph_, 0x05040100u), wq_, y[16 * ch_ + 4 * i_ + 2], false); \
            y[16 * ch_ + 4 * i_ + 3] = __builtin_amdgcn_sdot4((int)__builtin_amdgcn_perm(qh_, ph_, 0x07060302u), wq_, y[16 * ch_ + 4 * i_ + 3], false); } } while (0)
    {
        v4u b0[8], b1[8], b2[8], b3[8];
        if (!(PMODE & 1)) { P7B_ISSUE(b0, 0, 0); P7B_ISSUE(b1, 0, 1); P7B_ISSUE(b2, 0, 2); }
        for (int j = 0; j < ((PMODE & 1) ? 0 : 8); ++j) {
            const int jn = j < 7 ? j + 1 : 7;
#ifdef MK_P7_RESYNC
            if (PMODE == 0 && (j & (MK_P7_RESYNC - 1)) == 0 && j) xcd_barrier(bar);
#endif
#pragma unroll
            for (int tp = 0; tp < 4; ++tp) {
#pragma unroll
                for (int half = 0; half < 2; ++half) {
                    const int tk = 2 * tp + half;
                    int y[32];
#pragma unroll
                    for (int i = 0; i < 32; ++i) y[i] = 0;
                    float* op = out + (mbase + tk) * 1024 + 128 * j + (g >> 3) * 64 + 16 * c + 2 * (g & 7);
#ifdef MK_HILO
                    f32x2_t ov = {0.f, 0.f}; if (!(PMODE & 16)) { const size_t eo_ = (mbase + tk) * 1024 + 128 * j + (g >> 3) * 64 + 16 * c + 2 * (g & 7);
                        const unsigned hi_ = *(const GAS unsigned*)(X1B + eo_), lo_ = *(const GAS unsigned*)(x1lo_ptr(ws, mbase + tk) + (eo_ & 1023));
                        ov = (f32x2_t){bf_lo(hi_) + bf_lo(lo_), bf_hi(hi_) + bf_hi(lo_)}; }
#else
                    f32x2_t ov = {0.f, 0.f}; if (!(PMODE & 16)) ov = *(const GAS f32x2_t*)op;
#endif
                    if (half == 0) {
                        P7B_ISSUE(b3, j, 4 * tp + 3); __builtin_amdgcn_sched_barrier(0);
                        P7B_MATH(b0, 4 * tp + 0); __builtin_amdgcn_sched_barrier(0);
                        if (tp < 3) P7B_ISSUE(b0, j, 4 * tp + 4); else P7B_ISSUE(b0, jn, 0);
                        __builtin_amdgcn_sched_barrier(0);
                        P7B_MATH(b1, 4 * tp + 1); __builtin_amdgcn_sched_barrier(0);
                    } else {
                        if (tp < 3) P7B_ISSUE(b1, j, 4 * tp + 5); else P7B_ISSUE(b1, jn, 1);
                        __builtin_amdgcn_sched_barrier(0);
                        P7B_MATH(b2, 4 * tp + 2); __builtin_amdgcn_sched_barrier(0);
                        if (tp < 3) P7B_ISSUE(b2, j, 4 * tp + 6); else P7B_ISSUE(b2, jn, 2);
                        __builtin_amdgcn_sched_barrier(0);
                        P7B_MATH(b3, 4 * tp + 3); __builtin_amdgcn_sched_barrier(0);
                    }
                    int z[16];
#pragma unroll
                    for (int k = 0; k < 16; ++k) { if (PMODE & 4) { z[k] = y[k] + y[16 + k]; } else { auto r = __builtin_amdgcn_permlane32_swap((unsigned)y[k], (unsigned)y[16 + k], false, false); z[k] = (int)r[0] + (int)r[1]; } }
                    int z2[8];
#pragma unroll
                    for (int k = 0; k < 8; ++k) { if (PMODE & 4) { z2[k] = z[k] + z[8 + k]; } else { auto r = __builtin_amdgcn_permlane16_swap((unsigned)z[k], (unsigned)z[8 + k], false, false); z2[k] = (int)r[0] + (int)r[1]; } }
                    int z3[4];
#pragma unroll
                    for (int k = 0; k < 4; ++k) { const int keep = (lane & 8) ? z2[4 + k] : z2[k], send = (lane & 8) ? z2[k] : z2[4 + k]; z3[k] = keep + __builtin_amdgcn_mov_dpp(send, 0x128, 0xf, 0xf, true); }
                    int z4[2];
#pragma unroll
                    for (int k = 0; k < 2; ++k) { const int keep = (lane & 4) ? z3[2 + k] : z3[k], send = (lane & 4) ? z3[k] : z3[2 + k];
                        z4[k] = keep + __builtin_amdgcn_mov_dpp(__builtin_amdgcn_mov_dpp(send, 0x1B, 0xf, 0xf, true), 0x141, 0xf, 0xf, true); }
                    f32x2_t res; res.x = ov.x + sw[tk] * (float)z4[0]; res.y = ov.y + sw[tk] * (float)z4[1];
                    if (!(PMODE & 16) || res.x == 12345.678f) *(GAS f32x2_t*)op = res;
                    __builtin_amdgcn_sched_barrier(0);
                }
            }
        }
    }
#undef P7B_ISSUE
#undef P7B_MATH
}

struct GrpBarrier { unsigned* cnt; unsigned* gen; unsigned* tmo; };
__device__ __forceinline__ void grp_barrier(const GrpBarrier& b) {
    asm volatile("s_waitcnt vmcnt(0)" ::: "memory");
    __syncthreads();
    if (threadIdx.x == 0) {
        __builtin_amdgcn_fence(__ATOMIC_RELEASE, "agent");
        asm volatile("s_waitcnt vmcnt(0)" ::: "memory");
        const unsigned old = xb_add(b.cnt, 1u); const unsigned gen = old / 32u;
        if (old + 1u == (gen + 1u) * 32u) xb_add(b.gen, 1u);
        else XB_SPIN(xb_ld(b.gen) == gen, b.tmo);
        __builtin_amdgcn_fence(__ATOMIC_ACQUIRE, "agent");
        asm volatile("s_waitcnt vmcnt(0)" ::: "memory");
    }
    __syncthreads();
}

__global__ void __launch_bounds__(NWAVES * 64, 2) mega_fwd(Args args) {
    extern __shared__ __attribute__((aligned(16))) unsigned char lds_raw[];
    LAS unsigned char* lds = (LAS unsigned char*)lds_raw;
    volatile LAS unsigned* MISC = (volatile LAS unsigned*)(lds + MISC_OFF);
    const int tid = threadIdx.x, lane = tid & 63, wave = __builtin_amdgcn_readfirstlane(tid >> 6);
    const int G = gridDim.x; const int bx = blockIdx.x; const int vcu = (G % 8 == 0) ? (bx % 8) * (G / 8) + bx / 8 : bx;
    const int gw = vcu * NWAVES + wave, NGW = G * NWAVES;
    const int grp = bx & 7, rank = bx >> 3;
    unsigned char* ws = args.ws;
    gu32* ctl = (gu32*)(ws + WS_CTL);
    for (int u = tid; u < (LDS_BYTES - LDSCTL_OFF) / 4; u += NWAVES * 64) ((LAS unsigned*)(lds + LDSCTL_OFF))[u] = 0u;
    __syncthreads();
    XcdBarrier bar = xcd_barrier_post((unsigned*)(ctl + CW_BAR), MISC + 8);
    const GrpBarrier gb{(unsigned*)(ctl + CW_GRP + 64 * grp), (unsigned*)(ctl + CW_GGEN + 64 * grp), (unsigned*)(ctl + CW_BAR)};
    if (G != 256) return;
    const int lo = args.ph_lo, hi = args.ph_hi;
#define IN(k) (lo <= (k) && (k) < hi)
#define BOTH(k) (IN(k) && IN((k) + 1))
    unsigned char* sl = ws + SLAB0 + (size_t)grp * SLAB;
    const size_t boff = (size_t)grp * SEQ;

    if (IN(0)) { p0_prologue(args, lds, gw, NGW, wave, lane); for (int u = vcu; u < 256; u += G) p0_wf_unit(args, lds, u, tid, lane, wave); if (BOTH(0)) xcd_barrier(bar); }

    if (IN(1)) {
        pg8::Gemm g{(const bf16*)(sl + OFF_H), (const bf16*)(ws + WS_WIN), SEQ, 2560, 1024}; pg8::GroupOrder S; S.init(SEQ, 2560, 32, rank);
        pg8::EpiProj E{(bf16*)(sl + OFF_Q), (bf16*)(sl + OFF_K), (bf16*)(sl + OFF_VV), (bf16*)(sl + OFF_UA), (bf16*)(sl + OFF_VA), args.in[3], args.in[4]};
        const int t0 = 2048 * grp, pre = TBL_PRE_PER_GROUP * grp;
        p0_tables(args, t0, t0 + pre, rank * NWAVES + wave, 32 * NWAVES, lane);
        pg8::gemm_phase<pg8::EpiProj, pg8::GroupOrder, true, true>(lds + RING_OFF, g, S, E);
        const int cut = t0 + pre + ((2048 - pre) * 13) / 16;
        if (rank >= 16) p0_tables(args, t0 + pre, cut, (rank - 16) * NWAVES + wave, 16 * NWAVES, lane); else p0_tables(args, cut, t0 + 2048, rank * NWAVES + wave, 16 * NWAVES, lane);
        if (BOTH(1)) grp_barrier(gb);
        if (tid == 0) (void)xb_add((unsigned*)(ctl + CW_TBL), 1u);
    }
    if (IN(2)) {
        { AttnStage st;
#define AU_OF(k) ((((rank + 32 * (k)) >> 6) << 9) + grp * 64 + ((rank + 32 * (k)) & 63))
          attn_issue(args, AU_OF(0), tid, st);
          for (int k = 0; k < 6; ++k) {
              const int au = AU_OF(k);
              attn_commit(args, lds, au, tid, st);
              __syncthreads();
              if (k + 1 < 6) attn_issue(args, AU_OF(k + 1), tid, st);
              attn_compute(args, lds, au, tid, lane, wave);
              __syncthreads();
          }
#undef AU_OF
          for (int k = 0; k < 2; ++k) sgu_unit(args, lds, grp * 64 + rank + 32 * k, tid, lane, wave); }
        if (BOTH(2)) grp_barrier(gb);
    }
    if (IN(3)) { p3_merge(args, grp, rank * NWAVES + wave, 32 * NWAVES, lane); if (BOTH(3)) grp_barrier(gb); }
    if (IN(4)) {
        pg8::Gemm g{(const bf16*)(sl + OFF_H), (const bf16*)(ws + WS_WOUT), SEQ, 1024, 1024}; pg8::GroupOrder S; S.init(SEQ, 1024, 32, rank);
        pg8::EpiOut E{args.in[0] + boff * 1024, args.out + boff * 1024, (bf16*)(sl + OFF_X1B), (float*)(ws + WS_ROWSQ) + boff * 16, (bf16*)(sl + OFF_LO), (bf16*)(sl + OFF_LO)};
        pg8::gemm_phase<pg8::EpiOut, pg8::GroupOrder, true, true>(lds + RING_OFF, g, S, E);
        if (BOTH(4)) grp_barrier(gb);
    }
    if (IN(5)) {
        pg8::Gemm g{(const bf16*)(sl + OFF_X1B), (const bf16*)(ws + WS_WQ), SEQ, 2048, 1024}; pg8::GroupOrder S; S.init(SEQ, 2048, 32, rank);
        pg8::EpiPQ E{(const float*)(ws + WS_ROWSQ) + boff * 16, (bf16*)(sl + OFF_SC)};
        pg8::gemm_phase<pg8::EpiPQ, pg8::GroupOrder, true, true>(lds + RING_OFF, g, S, E);
        if (BOTH(5) || (IN(5) && IN(7))) grp_barrier(gb);
    }
    if (IN(7)) {
        if (IN(1)) { if (tid == 0) { XB_SPIN(xb_ld((unsigned*)(ctl + CW_TBL)) < 256u, (unsigned*)(ctl + CW_BAR)); __builtin_amdgcn_fence(__ATOMIC_ACQUIRE, "agent"); asm volatile("s_waitcnt vmcnt(0)" ::: "memory"); } __syncthreads(); }
        p7_sliced<0>(args, lds, grp * 32 + rank, lane, wave, args.out, bar);
    }
#undef IN
#undef BOTH
}

#ifndef MK_CUTS
#define MK_CUTS 0
#endif
static void mega_launch(void* const* d_in, void* d_out, void* d_ws, hipStream_t stream, int ph_lo, int ph_hi, bool cuts) {
    static int grid = 0;
    if (grid == 0) {
        int dev = 0, cus = 0, per_cu = 0;
        if (hipGetDevice(&dev) != hipSuccess || hipDeviceGetAttribute(&cus, hipDeviceAttributeMultiprocessorCount, dev) != hipSuccess) { fprintf(stderr, "kernel_launch: device query failed\n"); grid = -1; return; }
        if (hipFuncSetAttribute((const void*)mega_fwd, hipFuncAttributeMaxDynamicSharedMemorySize, LDS_BYTES) != hipSuccess) { fprintf(stderr, "kernel_launch: hipFuncSetAttribute failed\n"); grid = -1; return; }
        if (hipOccupancyMaxActiveBlocksPerMultiprocessor(&per_cu, (const void*)mega_fwd, NWAVES * 64, LDS_BYTES) != hipSuccess || per_cu < 1) fprintf(stderr, "kernel_launch: occupancy query reports %d\n", per_cu);
        (void)hipGetLastError();
        grid = cus;
    }
    if (grid < 0) return;
    Args a{};
    for (int i = 0; i < 17; ++i) a.in[i] = (const float*)d_in[i];
    a.out = (float*)d_out; a.ws = (unsigned char*)d_ws;
    if (!cuts) { (void)hipMemsetAsync((char*)d_ws + WS_CTL, 0, CTL_ZERO_BYTES, stream); a.ph_lo = ph_lo; a.ph_hi = ph_hi; hipLaunchKernelGGL(mega_fwd, dim3(grid), dim3(NWAVES * 64), LDS_BYTES, stream, a); }
    else for (int p = ph_lo; p < ph_hi; ++p) { (void)hipMemsetAsync((char*)d_ws + WS_CTL, 0, CTL_ZERO_BYTES, stream); a.ph_lo = p; a.ph_hi = p + 1; hipLaunchKernelGGL(mega_fwd, dim3(grid), dim3(NWAVES * 64), LDS_BYTES, stream, a); }
    const hipError_t le = hipPeekAtLastError();
    if (le != hipSuccess) fprintf(stderr, "kernel_launch: launch failed: %s\n", hipGetErrorName(le));
}

extern "C" void kernel_launch(void* const* d_in, const int* in_sizes, int n_in, void* d_out, int out_size, void* d_ws, size_t ws_size, hipStream_t stream) {
    mega_launch(d_in, d_out, d_ws, stream, 0, 8, MK_CUTS != 0);
}
```

```cpp
#define MK_TBL_PRE 5120
#define MK_HILO 1
#define MK_X1_BF16 1
#include <hip/hip_runtime.h>
#include <cstdio>
#include <cstdint>
#include <cmath>
namespace pg8 {
#define PG8_LAS __attribute__((address_space(3)))
typedef unsigned short bf16_t;
typedef short bf16x8 __attribute__((ext_vector_type(8)));
typedef float f32x4 __attribute__((ext_vector_type(4)));
typedef unsigned u32x4 __attribute__((ext_vector_type(4)));
constexpr int BM = 256, BK = 64, HALF = 128, HTB = HALF * BK * 2  , STAGE_BYTES = 8 * HTB, NXCD = 8, WGM = 8;

__host__ __device__ __forceinline__ int lds_byte(int r, int c) { const int st = (r >> 4) * 2 + (c >> 5), rr = r & 15, cc = c & 31, ob = rr * 64 + cc * 2; return st * 1024 + (ob ^ (((ob >> 9) & 1) << 5)); }
__host__ __device__ __forceinline__ void stage_rc(int b, int& R, int& C) { const int st = b / 1024, sb = b % 1024, swz = sb ^ (((sb >> 9) & 1) << 5); R = (st >> 1) * 16 + swz / 64; C = (st & 1) * 32 + (swz % 64) / 2; }
__host__ __device__ __forceinline__ int perm32(int rho) { const int n = rho >> 4, i = rho & 15; return 8 * (i >> 2) + 4 * n + (i & 3); }

struct Unit { int pm, pn; };
struct Gemm { const bf16_t* A; const bf16_t* Bt; int M, N, K; };

struct StaticOrder {
    int nM, nN, nwg, G, c;
    __host__ __device__ void init(int M, int N, int G_, int c_) { nM = M / BM; nN = N / BM; nwg = nM * nN; G = G_; c = c_; }
    __host__ __device__ bool next(int i, Unit& u) const {
        const long L = (long)i * G + c; if (L >= nwg) return false;
        int wgid = (int)L; { const int q = nwg / NXCD, r = nwg % NXCD, xcd = wgid % NXCD, off = wgid / NXCD; wgid = (xcd < r ? xcd * (q + 1) : r * (q + 1) + (xcd - r) * q) + off; }
        const int nig = WGM * nN, gid = wgid / nig, fm = gid * WGM, gsz = (nM - fm) < WGM ? (nM - fm) : WGM;
        u.pm = fm + ((wgid % nig) % gsz); u.pn = (wgid % nig) / gsz; return true;
    }
    __device__ __forceinline__ void a_ready(const Unit&) const {}
    __device__ __forceinline__ void done(const Unit&) const {}
};


typedef float f32x2_t __attribute__((ext_vector_type(2))); typedef __bf16 bf16x2_t __attribute__((ext_vector_type(2)));
__device__ __forceinline__ unsigned cvtpk(float lo, float hi) { f32x2_t v = {lo, hi}; bf16x2_t b = __builtin_convertvector(v, bf16x2_t); return __builtin_bit_cast(unsigned, b); }
__device__ __forceinline__ float gelu_tanh_f(float x) {
    const float u2 = x * (1.5957691216057308f + 0.07135481627260025f * x * x);
    return x * __builtin_amdgcn_rcpf(1.0f + __builtin_amdgcn_exp2f(-1.4426950408889634f * u2));
}
__device__ __forceinline__ unsigned cvtpk_h(float lo, float hi) { typedef _Float16 h2_t __attribute__((ext_vector_type(2))); f32x2_t v = {lo, hi}; h2_t b = __builtin_convertvector(v, h2_t); return __builtin_bit_cast(unsigned, b); }
constexpr float QSCALE = 0.125f * 1.4426950408889634f;
constexpr float RMS_EPS = 1e-6f;

struct EpiProj {
    static constexpr bool PERM = true, AFTER_DRAIN = false;
    bf16_t *Q, *K, *V, *UA, *VA; const float *qw, *kw;
    __device__ __forceinline__ void operator()(const f32x4 (&acc)[2][2][4][2], const Unit& u, int wr, int wc, int fr, int fq) const {
        const int kind = u.pn >> 1;
        const int cin = (u.pn & 1) * 256 + wc * 64;
        bf16_t* dst = kind == 0 ? Q : kind == 1 ? K : kind == 2 ? V : kind == 3 ? UA : VA;
        f32x4 wv[2][2];
        if (kind < 2) { const float* w = kind == 0 ? qw : kw;
#pragma unroll
            for (int bj = 0; bj < 2; ++bj)
#pragma unroll
                for (int n = 0; n < 2; ++n) wv[bj][n] = *(const f32x4*)(w + 32 * bj + 8 * fq + 4 * n); }
#pragma unroll
        for (int ai = 0; ai < 2; ++ai)
#pragma unroll
            for (int m = 0; m < 4; ++m) {
                const int row = u.pm * BM + ai * HALF + wr * 64 + m * 16 + fr;
                f32x4 v[2][2];
#pragma unroll
                for (int bj = 0; bj < 2; ++bj)
#pragma unroll
                    for (int n = 0; n < 2; ++n) v[bj][n] = acc[ai][bj][m][n];
                if (kind < 2) {
                    float ss = 0.f;
#pragma unroll
                    for (int bj = 0; bj < 2; ++bj)
#pragma unroll
                        for (int n = 0; n < 2; ++n) { const f32x4 x = v[bj][n]; ss += (x[0] * x[0] + x[1] * x[1]) + (x[2] * x[2] + x[3] * x[3]); }
                    ss += __shfl_xor(ss, 16); ss += __shfl_xor(ss, 32);
                    const float r = rsqrtf(ss * (1.0f / 64.0f) + RMS_EPS) * (kind == 0 ? QSCALE : 1.0f);
#pragma unroll
                    for (int bj = 0; bj < 2; ++bj)
#pragma unroll
                        for (int n = 0; n < 2; ++n) v[bj][n] = v[bj][n] * r * wv[bj][n];
                } else if (kind >= 3) {
#pragma unroll
                    for (int bj = 0; bj < 2; ++bj)
#pragma unroll
                        for (int n = 0; n < 2; ++n)
#pragma unroll
                            for (int i = 0; i < 4; ++i) v[bj][n][i] = gelu_tanh_f(v[bj][n][i]);
                }
                bf16_t* rowp = dst + (size_t)row * 512 + cin + 8 * fq;
#pragma unroll
                for (int bj = 0; bj < 2; ++bj) { u32x4 w; w.x = cvtpk(v[bj][0][0], v[bj][0][1]); w.y = cvtpk(v[bj][0][2], v[bj][0][3]); w.z = cvtpk(v[bj][1][0], v[bj][1][1]); w.w = cvtpk(v[bj][1][2], v[bj][1][3]);
                    *(u32x4*)(rowp + 32 * bj) = w; }
            }
    }
};

struct EpiOut {
    static constexpr bool PERM = true, AFTER_DRAIN = false;
    const float* x; float* out; bf16_t* X1B; float* rowsq; bf16_t* loA; bf16_t* loB;
    __device__ __forceinline__ void operator()(const f32x4 (&acc)[2][2][4][2], const Unit& u, int wr, int wc, int fr, int fq) const {
        const int col0 = u.pn * BM + wc * 64 + 8 * fq;
#pragma unroll
        for (int ai = 0; ai < 2; ++ai)
#pragma unroll
            for (int m = 0; m < 4; ++m) {
                const int row = u.pm * BM + ai * HALF + wr * 64 + m * 16 + fr; const size_t off = (size_t)row * 1024 + col0;
                float ss = 0.f;
#pragma unroll
                for (int bj = 0; bj < 2; ++bj) {
                    const f32x4 r0 = *(const f32x4*)(x + off + 32 * bj), r1 = *(const f32x4*)(x + off + 32 * bj + 4);
                    const f32x4 a = acc[ai][bj][m][0] + r0, b = acc[ai][bj][m][1] + r1;
                    ss += (a[0] * a[0] + a[1] * a[1]) + (a[2] * a[2] + a[3] * a[3]) + (b[0] * b[0] + b[1] * b[1]) + (b[2] * b[2] + b[3] * b[3]);
                    u32x4 w; w.x = cvtpk(a[0], a[1]); w.y = cvtpk(a[2], a[3]); w.z = cvtpk(b[0], b[1]); w.w = cvtpk(b[2], b[3]);
                    *(u32x4*)(X1B + off + 32 * bj) = w;
#if defined(MK_HILO) && !defined(MK_X1_BF16)
                    u32x4 l;
                    l.x = cvtpk(a[0] - __uint_as_float(w.x << 16), a[1] - __uint_as_float(w.x & 0xffff0000u)); l.y = cvtpk(a[2] - __uint_as_float(w.y << 16), a[3] - __uint_as_float(w.y & 0xffff0000u));
                    l.z = cvtpk(b[0] - __uint_as_float(w.z << 16), b[1] - __uint_as_float(w.z & 0xffff0000u)); l.w = cvtpk(b[2] - __uint_as_float(w.w << 16), b[3] - __uint_as_float(w.w & 0xffff0000u));
                    bf16_t* lop = row < 8192 ? loA + off : loB + (off - (size_t)8192 * 1024);
                    *(u32x4*)(lop + 32 * bj) = l;
#elif defined(MK_X1_BF16)
#else
                    *(f32x4*)(out + off + 32 * bj) = a; *(f32x4*)(out + off + 32 * bj + 4) = b;
#endif
                }
                ss += __shfl_xor(ss, 16); ss += __shfl_xor(ss, 32);
                if (fq == 0) rowsq[(size_t)row * 16 + u.pn * 4 + wc] = ss;
            }
    }
};

struct EpiPQ {
    static constexpr bool PERM = true, AFTER_DRAIN = false;
    const float* rowsq; bf16_t* PQ;
    __device__ __forceinline__ void operator()(const f32x4 (&acc)[2][2][4][2], const Unit& u, int wr, int wc, int fr, int fq) const {
        const int col0 = u.pn * BM + wc * 64 + 8 * fq;
#pragma unroll
        for (int ai = 0; ai < 2; ++ai)
#pragma unroll
            for (int m = 0; m < 4; ++m) {
                const int row = u.pm * BM + ai * HALF + wr * 64 + m * 16 + fr;
                const f32x4* rq = (const f32x4*)(rowsq + (size_t)row * 16);
                const f32x4 s0 = rq[0], s1 = rq[1], s2 = rq[2], s3 = rq[3];
                const float ss = ((s0[0] + s0[1]) + (s0[2] + s0[3])) + ((s1[0] + s1[1]) + (s1[2] + s1[3])) + ((s2[0] + s2[1]) + (s2[2] + s2[3])) + ((s3[0] + s3[1]) + (s3[2] + s3[3]));
                const float r = rsqrtf(ss * (1.0f / 1024.0f) + RMS_EPS);
                bf16_t* rowp = PQ + (size_t)row * 2048 + col0;
#pragma unroll
                for (int bj = 0; bj < 2; ++bj) { const f32x4 a = acc[ai][bj][m][0] * r, b = acc[ai][bj][m][1] * r;
                    u32x4 w; w.x = cvtpk_h(a[0], a[1]); w.y = cvtpk_h(a[2], a[3]); w.z = cvtpk_h(b[0], b[1]); w.w = cvtpk_h(b[2], b[3]);
                    *(u32x4*)(rowp + 32 * bj) = w; }
            }
    }
};

template <class Epi, class Sched, bool ALIGN_EPI = false, bool SP2 = false>
__device__ __forceinline__ void gemm_phase(PG8_LAS unsigned char* lds, const Gemm g, const Sched& S, const Epi& E) {
    const int tid = threadIdx.x, wid = __builtin_amdgcn_readfirstlane(tid >> 6), lane = tid & 63, wr = wid >> 2, wc = wid & 3, fr = lane & 15, fq = lane >> 4;
    const int K = g.K, nt = K / BK;
    unsigned voffA[2], voffB[2];
#pragma unroll
    for (int i = 0; i < 2; ++i) { int R, C; stage_rc(tid * 16 + i * 8192, R, C); const int Rb = Epi::PERM ? ((R & ~31) + perm32(R & 31)) : R;
        voffA[i] = (unsigned)(R * K + C) * 2u; voffB[i] = (unsigned)(Rb * K + C) * 2u; }
    const size_t kstep = (size_t)(BK * 2);
    const size_t hstep = (size_t)HALF * K * 2;
    const size_t tstep = 2 * hstep;
    const unsigned ldsw = (unsigned)wid * 1024u;
    const int aoff = lds_byte(wr * 64 + fr, fq * 8), boff = lds_byte(wc * 32 + fr, fq * 8);
#define PG8_SA(b, h) (((b) * 2 + (h)) * HTB)
#define PG8_SB(b, h) ((4 + (b) * 2 + (h)) * HTB)
#define PG8_STAGE(bufoff, gbase, voff) do { _Pragma("unroll") for (int _i = 0; _i < 2; ++_i) \
        __builtin_amdgcn_global_load_lds((const unsigned*)((const char*)(gbase) + (voff)[_i]), (PG8_LAS unsigned*)(lds + (bufoff) + ldsw + _i * 8192), 16, 0, 0); } while (0)
#define PG8_LDA(dst, b, h) do { _Pragma("unroll") for (int m = 0; m < 4; ++m) _Pragma("unroll") for (int k = 0; k < 2; ++k) dst[m][k] = *(const PG8_LAS bf16x8*)(lds + PG8_SA(b, h) + aoff + m * 2048 + k * 1024); } while (0)
#define PG8_LDB(dst, b, h) do { _Pragma("unroll") for (int n = 0; n < 2; ++n) _Pragma("unroll") for (int k = 0; k < 2; ++k) dst[n][k] = *(const PG8_LAS bf16x8*)(lds + PG8_SB(b, h) + boff + n * 2048 + k * 1024); } while (0)
#define PG8_MMA(ai, bj, At, Bt) do { __builtin_amdgcn_s_setprio(1); _Pragma("unroll") for (int m = 0; m < 4; ++m) _Pragma("unroll") for (int n = 0; n < 2; ++n) _Pragma("unroll") for (int k = 0; k < 2; ++k) \
        acc[ai][bj][m][n] = __builtin_amdgcn_mfma_f32_16x16x32_bf16(Bt[n][k], At[m][k], acc[ai][bj][m][n], 0, 0, 0); __builtin_amdgcn_s_setprio(0); } while (0)
#define PG8_WAIT_V(n) asm volatile("s_waitcnt vmcnt(" #n ")" ::: "memory")
#define PG8_WAIT_L(n) asm volatile("s_waitcnt lgkmcnt(" #n ")" ::: "memory")
#define PG8_BAR __builtin_amdgcn_s_barrier()
#define PG8_SCHED __builtin_amdgcn_sched_barrier(0)
    Unit cur, nxt; int ui = 0;
    if (!S.next(0, cur)) return;
    f32x4 acc[2][2][4][2];
#pragma unroll
    for (int a = 0; a < 2; ++a)
#pragma unroll
        for (int b = 0; b < 2; ++b)
#pragma unroll
            for (int m = 0; m < 4; ++m)
#pragma unroll
                for (int n = 0; n < 2; ++n) acc[a][b][m][n] = (f32x4){0.f, 0.f, 0.f, 0.f};
    bf16x8 At[4][2], B0[2][2], B1[2][2];
    const char* cA = (const char*)g.A + (size_t)cur.pm * tstep; const char* cB = (const char*)g.Bt + (size_t)cur.pn * tstep;
    S.a_ready(cur);
    if constexpr (SP2) {
        PG8_STAGE(PG8_SB(0, 0), cB, voffB); PG8_STAGE(PG8_SB(0, 1), cB + hstep, voffB); PG8_STAGE(PG8_SA(0, 0), cA, voffA); PG8_STAGE(PG8_SA(0, 1), cA + hstep, voffA);
        if (wr == 1) PG8_BAR;
        PG8_WAIT_V(2); PG8_BAR;
        PG8_STAGE(PG8_SB(1, 0), cB + kstep, voffB); PG8_STAGE(PG8_SA(1, 0), cA + kstep, voffA); PG8_STAGE(PG8_SB(1, 1), cB + hstep + kstep, voffB);
        PG8_WAIT_V(6); PG8_BAR;
    } else {
        PG8_STAGE(PG8_SB(0, 0), cB, voffB); PG8_STAGE(PG8_SA(0, 0), cA, voffA); PG8_STAGE(PG8_SB(0, 1), cB + hstep, voffB); PG8_STAGE(PG8_SA(0, 1), cA + hstep, voffA);
        if (wr == 1) PG8_BAR;
        PG8_WAIT_V(4); PG8_BAR;
        PG8_STAGE(PG8_SB(1, 0), cB + kstep, voffB); PG8_STAGE(PG8_SA(1, 0), cA + kstep, voffA); PG8_STAGE(PG8_SB(1, 1), cB + hstep + kstep, voffB);
        PG8_WAIT_V(6); PG8_BAR;
    }
    for (;;) {
        const bool has_next = S.next(ui + 1, nxt);
        const char* nA = has_next ? (const char*)g.A + (size_t)nxt.pm * tstep : cA; const char* nB = has_next ? (const char*)g.Bt + (size_t)nxt.pn * tstep : cB;
        for (int t = 0; t < nt; t += 2) {
            const bool last = (t == nt - 2);
            const char* a1 = cA + (size_t)(t + 1) * kstep;
            const char* a2 = last ? nA : cA + (size_t)(t + 2) * kstep; const char* b2 = last ? nB : cB + (size_t)(t + 2) * kstep;
            const char* a3 = a2 + kstep; const char* b3 = b2 + kstep;
            if (last && has_next) S.a_ready(nxt);
            if constexpr (SP2) {
            PG8_LDB(B0, 0, 0); PG8_LDB(B1, 0, 1); PG8_SCHED; PG8_LDA(At, 0, 0); PG8_STAGE(PG8_SA(1, 1), a1 + hstep, voffA);
            PG8_WAIT_V(8); PG8_WAIT_L(0); PG8_BAR; PG8_MMA(0, 0, At, B0); PG8_MMA(0, 1, At, B1); PG8_BAR; PG8_SCHED;
            PG8_LDA(At, 0, 1); PG8_STAGE(PG8_SB(0, 0), b2, voffB); PG8_STAGE(PG8_SB(0, 1), b2 + hstep, voffB); PG8_STAGE(PG8_SA(0, 0), a2, voffA);
            PG8_WAIT_V(8); PG8_WAIT_L(0); PG8_BAR; PG8_MMA(1, 0, At, B0); PG8_MMA(1, 1, At, B1); PG8_BAR; PG8_SCHED;
            PG8_LDB(B0, 1, 0); PG8_LDB(B1, 1, 1); PG8_SCHED; PG8_LDA(At, 1, 0); PG8_STAGE(PG8_SA(0, 1), a2 + hstep, voffA);
            PG8_WAIT_V(8); PG8_WAIT_L(0); PG8_BAR; PG8_MMA(0, 0, At, B0); PG8_MMA(0, 1, At, B1); PG8_BAR; PG8_SCHED;
            PG8_LDA(At, 1, 1); PG8_STAGE(PG8_SB(1, 0), b3, voffB); PG8_STAGE(PG8_SB(1, 1), b3 + hstep, voffB); PG8_STAGE(PG8_SA(1, 0), a3, voffA);
            PG8_WAIT_V(8); PG8_WAIT_L(0); PG8_BAR; PG8_MMA(1, 0, At, B0); PG8_MMA(1, 1, At, B1); PG8_BAR; PG8_SCHED;
            } else {
            PG8_LDB(B0, 0, 0); PG8_SCHED; PG8_LDA(At, 0, 0); PG8_STAGE(PG8_SA(1, 1), a1 + hstep, voffA);
            PG8_WAIT_L(8); PG8_BAR; PG8_WAIT_L(0); PG8_MMA(0, 0, At, B0); PG8_BAR; PG8_SCHED;
            PG8_LDB(B1, 0, 1); PG8_STAGE(PG8_SB(0, 0), b2, voffB);
            PG8_BAR; PG8_WAIT_L(0); PG8_MMA(0, 1, At, B1); PG8_BAR;
            PG8_LDA(At, 0, 1); PG8_STAGE(PG8_SA(0, 0), a2, voffA);
            PG8_BAR; PG8_WAIT_L(0); PG8_MMA(1, 0, At, B0); PG8_BAR; PG8_SCHED;
            PG8_STAGE(PG8_SB(0, 1), b2 + hstep, voffB);
            PG8_WAIT_V(6); PG8_BAR; PG8_MMA(1, 1, At, B1); PG8_BAR;
            PG8_LDB(B0, 1, 0); PG8_SCHED; PG8_LDA(At, 1, 0); PG8_STAGE(PG8_SA(0, 1), a2 + hstep, voffA);
            PG8_WAIT_L(8); PG8_BAR; PG8_WAIT_L(0); PG8_MMA(0, 0, At, B0); PG8_BAR; PG8_SCHED;
            PG8_LDB(B1, 1, 1); PG8_STAGE(PG8_SB(1, 0), b3, voffB);
            PG8_BAR; PG8_WAIT_L(0); PG8_MMA(0, 1, At, B1); PG8_BAR;
            PG8_LDA(At, 1, 1); PG8_STAGE(PG8_SA(1, 0), a3, voffA);
            PG8_BAR; PG8_WAIT_L(0); PG8_MMA(1, 0, At, B0); PG8_BAR; PG8_SCHED;
            PG8_STAGE(PG8_SB(1, 1), b3 + hstep, voffB);
            PG8_WAIT_V(6); PG8_BAR; PG8_MMA(1, 1, At, B1); PG8_BAR;
            }
        }
        if constexpr (ALIGN_EPI) { if (wr == 0) PG8_BAR; }
        if constexpr (!Epi::AFTER_DRAIN) { E(acc, cur, wr, wc, fr, fq); S.done(cur); }
        if (!has_next) break;
#pragma unroll
        for (int a = 0; a < 2; ++a)
#pragma unroll
            for (int b = 0; b < 2; ++b)
#pragma unroll
                for (int m = 0; m < 4; ++m)
#pragma unroll
                    for (int n = 0; n < 2; ++n) acc[a][b][m][n] = (f32x4){0.f, 0.f, 0.f, 0.f};
        cur = nxt; cA = nA; cB = nB; ++ui;
        if constexpr (ALIGN_EPI) { if (wr == 1) PG8_BAR; }
    }
    PG8_WAIT_V(0);
    if constexpr (!ALIGN_EPI) { if (wr == 0) PG8_BAR; }
    PG8_BAR;
    if constexpr (Epi::AFTER_DRAIN) { E.fused(acc, cur, wr, wc, fr, fq, lds, wid, lane); S.done(cur); }
#undef PG8_SA
#undef PG8_SB
#undef PG8_STAGE
#undef PG8_LDA
#undef PG8_LDB
#undef PG8_MMA
#undef PG8_WAIT_V
#undef PG8_WAIT_L
#undef PG8_BAR
#undef PG8_SCHED
}
}

constexpr int NWAVES = 8;
constexpr int T = 16384, DM = 1024, SEQ = 2048;
constexpr float EPS = 1e-6f;
constexpr float LOG2E = 1.4426950408889634f;

constexpr size_t MiB = 1u << 20;
constexpr size_t WS_CTL = 0, CTL_ZERO_BYTES = 1 * MiB;
constexpr size_t WS_BIAS = 1 * MiB;
constexpr size_t WS_KEYS = 1 * MiB + 64 * 1024;
constexpr size_t WS_WIN = 2 * MiB, WS_WOUT = 7 * MiB, WS_WQ = 9 * MiB;
constexpr size_t WS_ROWSQ = 13 * MiB;
constexpr size_t WS_U = 16 * MiB, WS_V = 48 * MiB;
constexpr size_t WS_SU = 32 * MiB, WS_SV = 33 * MiB;
constexpr size_t WS_H = 80 * MiB;
constexpr size_t WS_Q = 112 * MiB, WS_K = 128 * MiB, WS_VV = 144 * MiB;
constexpr size_t WS_X1B = 112 * MiB;
constexpr size_t WS_UA = 160 * MiB, WS_VA = 176 * MiB;
constexpr size_t WS_OP = 192 * MiB;
constexpr size_t WS_LSE = 240 * MiB;
constexpr size_t WS_PQ = 160 * MiB;
constexpr size_t WS_SEL = 80 * MiB;
constexpr size_t WS_X1LO_A = 144 * MiB, WS_X1LO_B = 224 * MiB;
constexpr size_t WS_END = 242 * MiB;
constexpr int CW_BAR = 4096;

constexpr int RING_OFF = 0, RING_BYTES = 131072;
constexpr int LDSCTL_OFF = RING_BYTES, MISC_OFF = LDSCTL_OFF + 320;
constexpr int LDS_BYTES = 147456;

#define GAS __attribute__((address_space(1)))
#define LAS __attribute__((address_space(3)))
typedef unsigned short bf16;
typedef unsigned v4u __attribute__((ext_vector_type(4)));
typedef unsigned v2u __attribute__((ext_vector_type(2)));
typedef float f32x4 __attribute__((ext_vector_type(4)));
typedef float f32x16 __attribute__((ext_vector_type(16)));
typedef short bf16x8 __attribute__((ext_vector_type(8)));
typedef short s16x4 __attribute__((ext_vector_type(4)));
typedef short v4i16_t __attribute__((ext_vector_type(4)));
typedef __bf16 bf16x2 __attribute__((ext_vector_type(2)));
typedef GAS unsigned gu32;
#define RLX_AGENT __ATOMIC_RELAXED, __HIP_MEMORY_SCOPE_AGENT
#define LDS_WAIT() asm volatile("s_waitcnt lgkmcnt(0)" ::: "memory")
using pg8::cvtpk; using pg8::gelu_tanh_f; using pg8::f32x2_t;
__device__ __forceinline__ float bf_lo(unsigned w) { return __uint_as_float(w << 16); }
__device__ __forceinline__ float bf_hi(unsigned w) { return __uint_as_float(w & 0xffff0000u); }
__device__ __forceinline__ float dot2_bf16(unsigned w, unsigned x, float acc) { return __builtin_amdgcn_fdot2_f32_bf16(__builtin_bit_cast(bf16x2, w), __builtin_bit_cast(bf16x2, x), acc, false); }
template <int CTRL> __device__ __forceinline__ float dpp(float x) { return __builtin_bit_cast(float, __builtin_amdgcn_mov_dpp(__builtin_bit_cast(int, x), CTRL, 0xf, 0xf, true)); }
__device__ __forceinline__ float swap32_other(float x) {
    auto s = __builtin_amdgcn_permlane32_swap(__float_as_uint(x), __float_as_uint(x), false, false);
    return (threadIdx.x & 32) ? __uint_as_float(s[0]) : __uint_as_float(s[1]);
}
__device__ __forceinline__ float row16_sum(float x) {
    x += dpp<0xB1>(x); x += dpp<0x4E>(x); x += dpp<0x141>(x); x += dpp<0x128>(x); return x;
}
__device__ __forceinline__ float wave_sum(float x) {
    x = row16_sum(x);
    auto s = __builtin_amdgcn_permlane16_swap(__float_as_uint(x), __float_as_uint(x), false, false);
    x = __uint_as_float(s[0]) + __uint_as_float(s[1]);
    auto t = __builtin_amdgcn_permlane32_swap(__float_as_uint(x), __float_as_uint(x), false, false);
    return __uint_as_float(t[0]) + __uint_as_float(t[1]);
}
__device__ __forceinline__ s16x4 vtr(const LAS unsigned char* p) { return __builtin_bit_cast(s16x4, __builtin_amdgcn_ds_read_tr16_b64_v4i16((LAS v4i16_t*)p)); }
__device__ __forceinline__ const bf16* x1lo_ptr(const unsigned char* ws, size_t row) { return row < 8192 ? (const bf16*)(ws + WS_X1LO_A) + row * 1024 : (const bf16*)(ws + WS_X1LO_B) + (row - 8192) * 1024; }
__device__ __forceinline__ int crow(int r, int hi) { return (r & 3) + 8 * (r >> 2) + 4 * hi; }
#define XB_TMO      128
#define XB_XCNT(j)  (256  + 64 * (j))
#define XB_XSUB(j)  (1280 + 64 * (j))
#define XB_XGEN(j)  (2304 + 64 * (j))
#define XB_TOP      3328
#define XB_TOPGEN   3392
#define XCD_BAR_WORDS 3456
#define XB_SPIN_CAP (1u << 18)

__device__ __forceinline__ unsigned xb_ld(unsigned* p)              { return __hip_atomic_load(p, __ATOMIC_RELAXED, __HIP_MEMORY_SCOPE_AGENT); }
__device__ __forceinline__ unsigned xb_add(unsigned* p, unsigned v) { return __hip_atomic_fetch_add(p, v, __ATOMIC_RELAXED, __HIP_MEMORY_SCOPE_AGENT); }
__device__ __forceinline__ unsigned xb_xcc_id() { return (unsigned)__builtin_amdgcn_s_getreg((3 << 11) | 20) & 0xFu; }
#define XB_SPIN(cond, bar) do { unsigned _sp = 0; while (cond) { __builtin_amdgcn_s_sleep(1); \
    if ((++_sp & 255u) == 0u) { if (xb_ld(&(bar)[XB_TMO])) break; if (_sp > XB_SPIN_CAP) { atomicAdd(&(bar)[XB_TMO], 1u); break; } } } } while (0)

struct XcdBarrier {
    unsigned* bar; unsigned x;
    volatile LAS unsigned* st;
};

__device__ __forceinline__ XcdBarrier xcd_barrier_post(unsigned* bar, volatile LAS unsigned* st) {
    XcdBarrier b; b.bar = bar; b.x = xb_xcc_id(); b.st = st;
    if (threadIdx.x == 0) (void)xb_add(&bar[XB_XCNT(b.x)], 1u);
    return b;
}
__device__ __forceinline__ void xcd_barrier_complete(unsigned* bar, unsigned x, unsigned& nloc, unsigned& nx) {
    const unsigned G = gridDim.x * gridDim.y * gridDim.z;
    unsigned sum, cnt, mine, sp = 0u;
    for (;;) {
        sum = 0u; cnt = 0u; mine = 0u;
#pragma unroll
        for (unsigned j = 0; j < 16; ++j) { const unsigned c = xb_ld(&bar[XB_XCNT(j)]); sum += c; cnt += (c > 0u) ? 1u : 0u; mine = (j == x) ? c : mine; }
        if (sum == G) break;
        __builtin_amdgcn_s_sleep(1);
        if ((++sp & 255u) == 0u) { if (xb_ld(&bar[XB_TMO])) break; if (sp > XB_SPIN_CAP) { atomicAdd(&bar[XB_TMO], 1u); break; } }
    }
    nloc = mine > 0u ? mine : 1u; nx = cnt > 0u ? cnt : 1u;
}

__device__ __forceinline__ void xcd_barrier(const XcdBarrier& b) {
    asm volatile("s_waitcnt vmcnt(0)" ::: "memory");
    __syncthreads();
    if (threadIdx.x == 0) {
        unsigned* bar = b.bar;
        __builtin_amdgcn_s_waitcnt(0);
        unsigned nloc = b.st[0], nx = b.st[1];
        if (nloc == 0u) { xcd_barrier_complete(bar, b.x, nloc, nx); b.st[0] = nloc; b.st[1] = nx; }
        const unsigned old = xb_add(&bar[XB_XSUB(b.x)], 1u);
        const unsigned gen = old / nloc;
        if (old + 1u == (gen + 1u) * nloc) {
            __builtin_amdgcn_fence(__ATOMIC_RELEASE, "agent");
            asm volatile("s_waitcnt vmcnt(0)" ::: "memory");
            const unsigned og = xb_add(&bar[XB_TOP], 1u);
            const unsigned tg = og / nx;
            if (og + 1u == (tg + 1u) * nx) xb_add(&bar[XB_TOPGEN], 1u);
            else XB_SPIN(xb_ld(&bar[XB_TOPGEN]) == tg, bar);
            __builtin_amdgcn_fence(__ATOMIC_ACQUIRE, "agent");
            xb_add(&bar[XB_XGEN(b.x)], 1u);
            asm volatile("s_waitcnt vmcnt(0)" ::: "memory");
        } else {
            XB_SPIN(xb_ld(&bar[XB_XGEN(b.x)]) == gen, bar);
            __builtin_amdgcn_fence(__ATOMIC_ACQUIRE, "agent");
            asm volatile("s_waitcnt vmcnt(0)" ::: "memory");
        }
    }
    __syncthreads();
}

struct Args { const float* in[17]; float* out; unsigned char* ws; int ph_lo, ph_hi; };

__device__ __forceinline__ void p0_transpose_item(const float* W, int K, int N, bf16* WT, LAS float* scr, int item, int lane, const float* kscale) {
    const int nblk = N / 32, kb = item / nblk, nb = item % nblk, k0 = 64 * kb, n0 = 32 * nb;
    const int r0 = (n0 & ~255) + 128 * ((n0 >> 5) & 1) + 32 * ((n0 >> 6) & 3);
#pragma unroll 8
    for (int i = 0; i < 32; ++i) { const int kk = 2 * i + (lane >> 5); float v = W[(size_t)(k0 + kk) * N + n0 + (lane & 31)]; if (kscale) v *= kscale[k0 + kk]; scr[kk * 33 + (lane & 31)] = v; }
    LDS_WAIT(); asm volatile("" ::: "memory");
    const int c = lane & 7;
#pragma unroll
    for (int j = 0; j < 4; ++j) { const int n = (lane >> 3) + 8 * j; const LAS float* s = scr + (8 * c) * 33 + n;
        v4u o; o.x = cvtpk(s[0 * 33], s[1 * 33]); o.y = cvtpk(s[2 * 33], s[3 * 33]); o.z = cvtpk(s[4 * 33], s[5 * 33]); o.w = cvtpk(s[6 * 33], s[7 * 33]);
        *(GAS v4u*)(WT + (size_t)(r0 + n) * K + k0 + 8 * c) = o; }
    LDS_WAIT(); asm volatile("" ::: "memory");
}
__device__ __forceinline__ int t5_bucket(int dist) {
    if (dist < 16) return dist;
    const float v = logf((float)dist / 16.0f) / 4.852030263919617f * 16.0f;
    const int l = 16 + (int)v;
    return l < 31 ? l : 31;
}
__device__ __forceinline__ void p0_tables(const Args& A, int row_lo, int row_hi, int gw, int NGW, int lane) {
    unsigned char* ws = A.ws; const float* ln2 = A.in[10];
    { const float* pu = A.in[14]; const float* pv = A.in[15]; signed char* U8 = (signed char*)(ws + WS_U); unsigned char* V8 = (unsigned char*)(ws + WS_V);
      float* SU = (float*)(ws + WS_SU); float* SV = (float*)(ws + WS_SV);
      f32x4 lw[4];
#pragma unroll
      for (int i = 0; i < 4; ++i) lw[i] = *(const f32x4*)(ln2 + 16 * lane + 4 * i);
      for (int e = row_lo + gw; e < row_hi; e += NGW) {
        const GAS f32x4* ur = (const GAS f32x4*)(pu + (size_t)e * 1024 + 16 * lane); const GAS f32x4* vr = (const GAS f32x4*)(pv + (size_t)e * 1024 + 16 * lane);
        f32x4 u[4], v[4]; float am = 0.f, bm = 0.f;
#pragma unroll
        for (int i = 0; i < 4; ++i) { u[i] = ur[i] * lw[i]; v[i] = vr[i];
            am = fmaxf(am, fmaxf(fmaxf(fabsf(u[i].x), fabsf(u[i].y)), fmaxf(fabsf(u[i].z), fabsf(u[i].w))));
            bm = fmaxf(bm, fmaxf(fmaxf(fabsf(v[i].x), fabsf(v[i].y)), fmaxf(fabsf(v[i].z), fabsf(v[i].w)))); }
#pragma unroll
        for (int o = 1; o < 64; o <<= 1) { am = fmaxf(am, __shfl_xor(am, o)); bm = fmaxf(bm, __shfl_xor(bm, o)); }
        const float ia = am > 0.f ? 127.0f / am : 0.f, ib = bm > 0.f ? 127.0f / bm : 0.f;
        v4u ou, ov;
#pragma unroll
        for (int i = 0; i < 4; ++i) {
            const int q0 = (int)rintf(u[i].x * ia), q1 = (int)rintf(u[i].y * ia), q2 = (int)rintf(u[i].z * ia), q3 = (int)rintf(u[i].w * ia);
            ou[i] = (unsigned)(q0 & 0xff) | ((unsigned)(q1 & 0xff) << 8) | ((unsigned)(q2 & 0xff) << 16) | ((unsigned)(q3 & 0xff) << 24);
            const int r0 = (int)rintf(v[i].x * ib), r1 = (int)rintf(v[i].y * ib), r2 = (int)rintf(v[i].z * ib), r3 = (int)rintf(v[i].w * ib);
            ov[i] = (unsigned)(r0 & 0xff) | ((unsigned)(r1 & 0xff) << 8) | ((unsigned)(r2 & 0xff) << 16) | ((unsigned)(r3 & 0xff) << 24); }
        const size_t dst = ((size_t)(lane >> 3) * 16384 + e) * 128 + (lane & 7) * 16;
        *(GAS v4u*)(U8 + dst) = ou; *(GAS v4u*)(V8 + dst) = ov;
        if (lane == 0) { SU[e] = am > 0.f ? am * (1.0f / 127.0f) : 1.0f; SV[e] = bm * (1.0f / 127.0f); }
      } }
}
constexpr int WF_W = 0, WF_K = 64 * 129 * 4;
__device__ __forceinline__ void p0_wf_unit(const Args& A, LAS unsigned char* lds, int u, int tid, int lane, int w) {
    const float* wq = A.in[11]; const float* ln2 = A.in[10];
    const int kt = u >> 4, hh16 = u & 15, h = hh16 >> 1, half = hh16 & 1, k0 = 64 * kt, c0 = h * 256 + half * 128;
    const float* keys = (half ? A.in[13] : A.in[12]) + (size_t)h * 128 * 128;
    LAS float* Wt = (LAS float*)(lds + WF_W); LAS float* Kt = (LAS float*)(lds + WF_K);
    __syncthreads();
#pragma unroll
    for (int it = 0; it < 16; ++it) { const int i = tid + 512 * it, r = i >> 7, d = i & 127; Wt[r * 129 + d] = wq[(size_t)(k0 + r) * 2048 + c0 + d] * ln2[k0 + r]; }
#pragma unroll
    for (int it = 0; it < 32; ++it) { const int i = tid + 512 * it, r = i >> 7, d = i & 127; Kt[r * 129 + d] = keys[i]; }
    __syncthreads();
    const int mt = w >> 1, nt = w & 1, a = lane & 31, hh = lane >> 5;
    f32x16 acc;
#pragma unroll
    for (int r = 0; r < 16; ++r) acc[r] = 0.f;
    const LAS float* ap = Kt + (32 * mt + a) * 129 + hh; const LAS float* bp = Wt + (32 * nt + a) * 129 + hh;
#pragma unroll 8
    for (int s = 0; s < 64; ++s) acc = __builtin_amdgcn_mfma_f32_32x32x2f32(ap[2 * s], bp[2 * s], acc, 0, 0, 0);
    bf16* WT = (bf16*)(A.ws + WS_WQ);
#pragma unroll
    for (int r = 0; r < 16; ++r) { const int key = 32 * mt + crow(r, hh); const int n = c0 + key;
        const int row = (n & ~255) + 128 * ((n >> 5) & 1) + 32 * ((n >> 6) & 3) + (n & 31);
        WT[(size_t)row * 1024 + k0 + 32 * nt + a] = (bf16)(cvtpk(acc[r], 0.f) & 0xffffu); }
}
__device__ __forceinline__ void p0_prologue(const Args& A, LAS unsigned char* lds, int gw, int NGW, int wave, int lane) {
    unsigned char* ws = A.ws;
    LAS float* scr = (LAS float*)(lds + RING_OFF + wave * 16384);
    const float* w_in = A.in[2]; const float* w_out = A.in[9]; const float* w_q = A.in[11]; const float* ln2 = A.in[10];
    constexpr int I_IN = (1024 / 64) * (2560 / 32), I_OUT = (1024 / 64) * (1024 / 32), I_Q = (1024 / 64) * (2048 / 32);
    for (int it = gw; it < I_IN + I_OUT; it += NGW) {
        int r = it;
        if (r < I_IN) { p0_transpose_item(w_in, 1024, 2560, (bf16*)(ws + WS_WIN), scr, r, lane, nullptr); continue; } r -= I_IN;
        p0_transpose_item(w_out, 1024, 1024, (bf16*)(ws + WS_WOUT), scr, r, lane, nullptr);
    }
    { const float* x = A.in[0]; const float* ln1 = A.in[1]; bf16* H = (bf16*)(ws + WS_H);
      f32x4 wv[4];
#pragma unroll
      for (int j = 0; j < 4; ++j) wv[j] = *((const f32x4*)ln1 + lane + 64 * j);
      for (int m = gw; m < T; m += NGW) {
        const GAS f32x4* xr = (const GAS f32x4*)(x + (size_t)m * DM) + lane;
        f32x4 v[4]; float s = 0.f;
#pragma unroll
        for (int j = 0; j < 4; ++j) { v[j] = xr[64 * j]; s += (v[j].x * v[j].x + v[j].y * v[j].y) + (v[j].z * v[j].z + v[j].w * v[j].w); }
        const float r = rsqrtf(wave_sum(s) * (1.f / DM) + EPS);
        GAS v2u* o8 = (GAS v2u*)(H + (size_t)m * DM) + lane;
#pragma unroll
        for (int j = 0; j < 4; ++j) { const f32x4 y = v[j] * r * wv[j]; v2u o; o.x = cvtpk(y.x, y.y); o.y = cvtpk(y.z, y.w); o8[64 * j] = o; }
      } }
    { const float* rb = A.in[16]; float* BT = (float*)(ws + WS_BIAS);
      for (int i = gw * 64 + lane; i < 3 * 8 * 192; i += NGW * 64) {
        const int x = i % 192, h = (i / 192) & 7, p = i / (192 * 8); const int rel = 159 - x; const int dil = p == 0 ? 1 : (p == 1 ? 4 : 16);
        BT[i] = (rel >= 0 && rel <= 128) ? LOG2E * rb[t5_bucket(rel * dil) * 8 + h] : 0.f;
      } }
}

constexpr int AT_K = 0, AT_V = 49152, AT_Q = 98304, AT_BT = 131072 + 1024;
constexpr float NEGBIG = -1e30f;
struct AttnStage { v4u kr[6], vr[6], qr[4]; };
__device__ __forceinline__ void attn_decode(int au, int& p, int& b, int& h, int& dil, int& res0, int& i0) {
    p = au >> 9; const int idx = au & 511; b = idx >> 6; h = (idx >> 3) & 7; const int sub = idx & 7;
    if (p == 0) { dil = 1; res0 = 0; i0 = sub * 256; } else if (p == 1) { dil = 4; res0 = sub >> 1; i0 = (sub & 1) * 256; } else { dil = 16; res0 = sub * 2; i0 = 0; }
}
__device__ __forceinline__ void attn_issue(const Args& A, int au, int tid, AttnStage& st) {
    unsigned char* ws = A.ws;
    asm volatile("" : "+v"(tid));
    const bf16* Kg = (const bf16*)(ws + WS_K); const bf16* Vg = (const bf16*)(ws + WS_VV);
    int p, b, h, dil, res0, i0; attn_decode(au, p, b, h, dil, res0, i0);
    const size_t tokbase = (size_t)b * SEQ; const int c = tid & 7;
#pragma unroll
    for (int it = 0; it < 6; ++it) { const int R = (tid >> 3) + 64 * it; int tok; bool ok;
        if (p < 2) { const int ki = i0 - 128 + R; ok = ki >= 0; tok = res0 + dil * ki; } else { ok = R < 256; tok = res0 + (R >> 7) + 16 * (R & 127); }
        if (ok) { const size_t off = (tokbase + tok) * 512 + h * 64 + c * 8; st.kr[it] = *(const GAS v4u*)(Kg + off); st.vr[it] = *(const GAS v4u*)(Vg + off); } }
}
__device__ __forceinline__ void attn_issue_q(const Args& A, int au, int tid, AttnStage& st) {
    int p, b, h, dil, res0, i0; attn_decode(au, p, b, h, dil, res0, i0);
    asm volatile("" : "+v"(tid));
    const bf16* Qg = (const bf16*)(A.ws + WS_Q); const size_t tokbase = (size_t)b * SEQ; const int c = tid & 7;
#pragma unroll
    for (int it = 0; it < 4; ++it) { const int R = (tid >> 3) + 64 * it; const int tok = p < 2 ? res0 + dil * (i0 + R) : res0 + (R >> 7) + 16 * (R & 127);
        st.qr[it] = *(const GAS v4u*)(Qg + (tokbase + tok) * 512 + h * 64 + c * 8); }
}
template <bool QPRE = false> __device__ __forceinline__ void attn_commit(const Args& A, LAS unsigned char* lds, int au, int tid, const AttnStage& st) {
    int p, b, h, dil, res0, i0; attn_decode(au, p, b, h, dil, res0, i0);
    asm volatile("" : "+v"(tid));
    const int c = tid & 7;
#pragma unroll
    for (int it = 0; it < 6; ++it) { const int R = (tid >> 3) + 64 * it; const bool ok = p < 2 ? (i0 - 128 + R >= 0) : (R < 256);
        if (ok) { *(LAS v4u*)(lds + AT_K + R * 128 + 16 * (c ^ ((R >> 1) & 7))) = st.kr[it];
                  *(LAS v4u*)(lds + AT_V + (c >> 2) * 24576 + (R >> 4) * 1024 + (R & 15) * 64 + (c & 3) * 16) = st.vr[it]; } }
    if constexpr (QPRE) {
#pragma unroll
      for (int it = 0; it < 4; ++it) { const int R = (tid >> 3) + 64 * it; *(LAS v4u*)(lds + AT_Q + R * 128 + 16 * (c ^ ((R >> 1) & 7))) = st.qr[it]; }
    } else { const bf16* Qg = (const bf16*)(A.ws + WS_Q); const size_t tokbase = (size_t)b * SEQ; v4u qr[4];
#pragma unroll
      for (int it = 0; it < 4; ++it) { const int R = (tid >> 3) + 64 * it; const int tok = p < 2 ? res0 + dil * (i0 + R) : res0 + (R >> 7) + 16 * (R & 127);
        qr[it] = *(const GAS v4u*)(Qg + (tokbase + tok) * 512 + h * 64 + c * 8); }
#pragma unroll
      for (int it = 0; it < 4; ++it) { const int R = (tid >> 3) + 64 * it; *(LAS v4u*)(lds + AT_Q + R * 128 + 16 * (c ^ ((R >> 1) & 7))) = qr[it]; } }
    if (tid < 192) ((LAS float*)(lds + AT_BT))[tid] = ((const float*)(A.ws + WS_BIAS))[(p * 8 + h) * 192 + tid];
}
template <int VAR = 0, bool QPRE = false> __device__ __forceinline__ void attn_compute(const Args& A, LAS unsigned char* lds, int au, int tid, int lane, int w, int au_next = -1, AttnStage* stq = nullptr) {
    unsigned char* ws = A.ws;
    bf16* OP = (bf16*)(ws + WS_OP); float* LSE = (float*)(ws + WS_LSE);
    const int a = lane & 31, hh = lane >> 5;
    int p, b, h, dil, res0, i0; attn_decode(au, p, b, h, dil, res0, i0);
    const size_t tokbase = (size_t)b * SEQ;
    int q0, resw, rowoff;
    if (p < 2) { q0 = i0 + 32 * w; resw = res0; rowoff = 0; } else { q0 = 32 * (w & 3); resw = res0 + (w >> 2); rowoff = -128; }
    const int jmin = (4 - (q0 >> 5)) > 0 ? (4 - (q0 >> 5)) : 0;
    const size_t mq = tokbase + resw + (size_t)dil * (q0 + a);
    bf16x8 qf[4];
    { const int Rq = 32 * w + a; const LAS unsigned char* qp = lds + AT_Q + Rq * 128; const int sq = (Rq >> 1) & 7;
#pragma unroll
      for (int s = 0; s < 4; ++s) qf[s] = *(const LAS bf16x8*)(qp + 16 * ((2 * s + hh) ^ sq)); }
    const LAS float* rt = (const LAS float*)(lds + AT_BT) + (31 - a + 4 * hh);
    f32x16 S[5];
#pragma unroll
    for (int j = 0; j < 5; ++j) {
        if (j >= jmin) {
            const int Rk = 32 * (w + j) + rowoff + a;
#pragma unroll
            for (int r = 0; r < 16; ++r) S[j][r] = (VAR & 4) ? (float)(r + j) : rt[32 * j + (r & 3) + 8 * (r >> 2)];
            const LAS unsigned char* kp = lds + AT_K + Rk * 128; const int sw = (Rk >> 1) & 7;
            if (!(VAR & 2))
#pragma unroll
            for (int s = 0; s < 4; ++s) { const bf16x8 kf = *(const LAS bf16x8*)(kp + 16 * ((2 * s + hh) ^ sw)); S[j] = __builtin_amdgcn_mfma_f32_32x32x16_bf16(kf, qf[s], S[j], 0, 0, 0); }
            if (j == 0) {
#pragma unroll
                for (int r = 0; r < 16; ++r) if (crow(r, hh) < a) S[j][r] = NEGBIG;
            }
            if (j == 4) {
#pragma unroll
                for (int r = 0; r < 16; ++r) if (crow(r, hh) > a) S[j][r] = NEGBIG;
            }
        } else {
#pragma unroll
            for (int r = 0; r < 16; ++r) S[j][r] = NEGBIG;
        }
    }
    float mx = NEGBIG;
#pragma unroll
    for (int j = 0; j < 5; ++j)
#pragma unroll
        for (int r = 0; r < 16; ++r) mx = fmaxf(mx, S[j][r]);
    mx = fmaxf(mx, swap32_other(mx));
    float l = 0.f;
#pragma unroll
    for (int j = 0; j < 5; ++j)
#pragma unroll
        for (int r = 0; r < 16; ++r) { const float e = __builtin_amdgcn_exp2f(S[j][r] - mx); S[j][r] = e; l += e; }
    l += swap32_other(l);
    if constexpr (QPRE) { if (au_next >= 0) attn_issue_q(A, au_next, tid, *stq); }
    f32x16 o[2];
#pragma unroll
    for (int r = 0; r < 16; ++r) { o[0][r] = 0.f; o[1][r] = 0.f; }
    const LAS unsigned char* vb = lds + AT_V + ((lane >> 4) & 1) * 32 + (lane & 3) * 8 + (4 * hh + ((lane & 15) >> 2)) * 64;
#pragma unroll
    for (int j = 0; j < 5; ++j) {
        if (j >= jmin && !(VAR & 8)) {
            const int G0 = (32 * (w + j) + rowoff) >> 4;
#pragma unroll
            for (int s2 = 0; s2 < 2; ++s2) {
                v4u pw; pw.x = cvtpk(S[j][8 * s2 + 0], S[j][8 * s2 + 1]); pw.y = cvtpk(S[j][8 * s2 + 2], S[j][8 * s2 + 3]); pw.z = cvtpk(S[j][8 * s2 + 4], S[j][8 * s2 + 5]); pw.w = cvtpk(S[j][8 * s2 + 6], S[j][8 * s2 + 7]);
                const bf16x8 pf = __builtin_bit_cast(bf16x8, pw);
#pragma unroll
                for (int d0 = 0; d0 < 2; ++d0) {
                    const LAS unsigned char* vp = vb + d0 * 24576 + (G0 + s2) * 1024;
                    const s16x4 lo = vtr(vp), hi = vtr(vp + 512);
                    const bf16x8 vf = (bf16x8){lo[0], lo[1], lo[2], lo[3], hi[0], hi[1], hi[2], hi[3]};
                    o[d0] = __builtin_amdgcn_mfma_f32_32x32x16_bf16(vf, pf, o[d0], 0, 0, 0);
                }
            }
        }
    }
    const float inv = __builtin_amdgcn_rcpf(l);
    if (!(VAR & 16))
    { const int Rq = 32 * w + a; LAS unsigned char* op_ = lds + AT_Q + Rq * 128 + 8 * hh; const int sq = (Rq >> 1) & 7;
#pragma unroll
      for (int d0 = 0; d0 < 2; ++d0)
#pragma unroll
        for (int g4 = 0; g4 < 4; ++g4) { v2u ov; ov.x = cvtpk(o[d0][4 * g4 + 0] * inv, o[d0][4 * g4 + 1] * inv); ov.y = cvtpk(o[d0][4 * g4 + 2] * inv, o[d0][4 * g4 + 3] * inv);
            *(LAS v2u*)(op_ + 16 * ((4 * d0 + g4) ^ sq)) = ov; }
      asm volatile("s_waitcnt lgkmcnt(0)" ::: "memory");
#pragma unroll
      for (int it = 0; it < 4; ++it) { const int rr = (lane >> 3) + 8 * it, ch = lane & 7, Rr = 32 * w + rr;
        const v4u v = *(const LAS v4u*)(lds + AT_Q + Rr * 128 + 16 * (ch ^ ((Rr >> 1) & 7)));
        const size_t mrow = tokbase + resw + (size_t)dil * (q0 + rr);
        *(GAS v4u*)(OP + ((size_t)p * T + mrow) * 512 + h * 64 + ch * 8) = v; } }
    if (hh == 0 && (!(VAR & 16) || l == 12345.f)) LSE[((size_t)p * T + mq) * 8 + h] = mx + __builtin_amdgcn_logf(l) + ((VAR & 8) ? o[0][0] + o[1][5] : 0.f);
}

constexpr int SG_IMG = 0, SG_RSTD = 32768;
__device__ __forceinline__ void sgu_unit(const Args& A, LAS unsigned char* lds, int su, int tid, int lane, int w) {
    unsigned char* ws = A.ws;
    bf16* UA = (bf16*)(ws + WS_UA); const bf16* VA = (const bf16*)(ws + WS_VA);
    const float* nw = A.in[5]; const float* sw = A.in[6]; const float* sb = A.in[7];
    const int a = lane & 31, hh = lane >> 5;
    const int b = su >> 6, n = (su >> 2) & 15, g = su & 3; const size_t m0 = (size_t)b * SEQ + n * 128;
    { const int ch = tid & 15;
#pragma unroll
      for (int it = 0; it < 4; ++it) { const int s = (tid >> 4) + 32 * it;
        const v4u v = *(const GAS v4u*)(VA + (m0 + s) * 512 + g * 128 + ch * 8);
        float ss = 0.f;
#pragma unroll
        for (int i = 0; i < 4; ++i) { const float x0 = bf_lo(v[i]), x1 = bf_hi(v[i]); ss += x0 * x0 + x1 * x1; }
        ss = row16_sum(ss);
        *(LAS v4u*)(lds + SG_IMG + (ch >> 2) * 8192 + (s >> 4) * 1024 + (s & 15) * 64 + (ch & 3) * 16) = v;
        if (ch == 0) ((LAS float*)(lds + SG_RSTD))[s] = rsqrtf(ss * (1.0f / 128.0f) + EPS); } }
    __syncthreads();
    const int tt = w >> 1, t = 32 * tt + a;
    f32x16 acc[2];
#pragma unroll
    for (int r = 0; r < 16; ++r) { acc[0][r] = 0.f; acc[1][r] = 0.f; }
    const float* wrow = sw + ((size_t)(g * 128 + t)) * 128;
    const LAS unsigned char* vb = lds + SG_IMG + ((lane >> 4) & 1) * 32 + (lane & 3) * 8 + (4 * hh + ((lane & 15) >> 2)) * 64;
#pragma unroll
    for (int st = 0; st < 8; ++st) {
        if (st < 2 * tt + 2) {
            const int s0 = 16 * st + 4 * hh;
            const f32x4 w0 = *(const f32x4*)(wrow + s0), w1 = *(const f32x4*)(wrow + s0 + 8);
            const f32x4 r0 = *(const LAS f32x4*)(lds + SG_RSTD + 4 * s0), r1 = *(const LAS f32x4*)(lds + SG_RSTD + 4 * (s0 + 8));
            float e[8];
#pragma unroll
            for (int i = 0; i < 4; ++i) { e[i] = (s0 + i <= t) ? w0[i] * r0[i] : 0.f; e[4 + i] = (s0 + 8 + i <= t) ? w1[i] * r1[i] : 0.f; }
            v4u bw; bw.x = cvtpk(e[0], e[1]); bw.y = cvtpk(e[2], e[3]); bw.z = cvtpk(e[4], e[5]); bw.w = cvtpk(e[6], e[7]);
            const bf16x8 bfr = __builtin_bit_cast(bf16x8, bw);
#pragma unroll
            for (int cbi = 0; cbi < 2; ++cbi) { const int cb = 2 * (w & 1) + cbi;
                const LAS unsigned char* vp = vb + cb * 8192 + st * 1024;
                const s16x4 lo = vtr(vp), hi = vtr(vp + 512);
                const bf16x8 vf = (bf16x8){lo[0], lo[1], lo[2], lo[3], hi[0], hi[1], hi[2], hi[3]};
                acc[cbi] = __builtin_amdgcn_mfma_f32_32x32x16_bf16(vf, bfr, acc[cbi], 0, 0, 0); }
        }
    }
    const float bias = sb[g * 128 + t];
    bf16* urow = UA + (m0 + t) * 512 + g * 128;
#pragma unroll
    for (int cbi = 0; cbi < 2; ++cbi)
#pragma unroll
        for (int g4 = 0; g4 < 4; ++g4) { const int c0 = 32 * (2 * (w & 1) + cbi) + 8 * g4 + 4 * hh;
            const v2u uu = *(const GAS v2u*)(urow + c0); const f32x4 nv = *(const f32x4*)(nw + g * 128 + c0);
            const float y0 = bf_lo(uu.x) * (nv[0] * acc[cbi][4 * g4 + 0] + bias), y1 = bf_hi(uu.x) * (nv[1] * acc[cbi][4 * g4 + 1] + bias);
            const float y2 = bf_lo(uu.y) * (nv[2] * acc[cbi][4 * g4 + 2] + bias), y3 = bf_hi(uu.y) * (nv[3] * acc[cbi][4 * g4 + 3] + bias);
            v2u ov; ov.x = cvtpk(y0, y1); ov.y = cvtpk(y2, y3); *(GAS v2u*)(urow + c0) = ov; }
    __syncthreads();
}

__device__ __forceinline__ void p3_merge(const Args& A, int m_lo, int m_hi, int m_step, int lane) {
    unsigned char* ws = A.ws;
    const bf16* OP = (const bf16*)(ws + WS_OP); const float* LSE = (const float*)(ws + WS_LSE); const bf16* SG = (const bf16*)(ws + WS_UA); bf16* MIX = (bf16*)(ws + WS_H);
    const float* mw = A.in[8];
    const f32x4 wa0 = *(const f32x4*)(mw + 8 * lane), wa1 = *(const f32x4*)(mw + 8 * lane + 4), ws0 = *(const f32x4*)(mw + 512 + 8 * lane), ws1 = *(const f32x4*)(mw + 512 + 8 * lane + 4);
    for (int m = m_lo; m < m_hi; m += m_step) {
        const int h = lane >> 3;
        const float l0 = LSE[((size_t)0 * T + m) * 8 + h], l1 = LSE[((size_t)1 * T + m) * 8 + h], l2 = LSE[((size_t)2 * T + m) * 8 + h];
        const v4u o0 = *(const GAS v4u*)(OP + ((size_t)0 * T + m) * 512 + 8 * lane), o1 = *(const GAS v4u*)(OP + ((size_t)1 * T + m) * 512 + 8 * lane), o2 = *(const GAS v4u*)(OP + ((size_t)2 * T + m) * 512 + 8 * lane);
        const v4u sg = *(const GAS v4u*)(SG + (size_t)m * 512 + 8 * lane);
        const float mxl = fmaxf(l0, fmaxf(l1, l2));
        float e0 = __builtin_amdgcn_exp2f(l0 - mxl), e1 = __builtin_amdgcn_exp2f(l1 - mxl), e2 = __builtin_amdgcn_exp2f(l2 - mxl);
        const float inv = __builtin_amdgcn_rcpf(e0 + e1 + e2); e0 *= inv; e1 *= inv; e2 *= inv;
        float at[8], sv[8]; float ssa = 0.f, sss = 0.f;
#pragma unroll
        for (int i = 0; i < 4; ++i) {
            at[2 * i] = e0 * bf_lo(o0[i]) + e1 * bf_lo(o1[i]) + e2 * bf_lo(o2[i]); at[2 * i + 1] = e0 * bf_hi(o0[i]) + e1 * bf_hi(o1[i]) + e2 * bf_hi(o2[i]);
            sv[2 * i] = bf_lo(sg[i]); sv[2 * i + 1] = bf_hi(sg[i]);
            ssa += at[2 * i] * at[2 * i] + at[2 * i + 1] * at[2 * i + 1]; sss += sv[2 * i] * sv[2 * i] + sv[2 * i + 1] * sv[2 * i + 1];
        }
        const float ra = rsqrtf(wave_sum(ssa) * (1.0f / 512.0f) + EPS), rs = rsqrtf(wave_sum(sss) * (1.0f / 512.0f) + EPS);
        v4u oa, os;
        oa.x = cvtpk(at[0] * ra * wa0[0], at[1] * ra * wa0[1]); oa.y = cvtpk(at[2] * ra * wa0[2], at[3] * ra * wa0[3]); oa.z = cvtpk(at[4] * ra * wa1[0], at[5] * ra * wa1[1]); oa.w = cvtpk(at[6] * ra * wa1[2], at[7] * ra * wa1[3]);
        os.x = cvtpk(sv[0] * rs * ws0[0], sv[1] * rs * ws0[1]); os.y = cvtpk(sv[2] * rs * ws0[2], sv[3] * rs * ws0[3]); os.z = cvtpk(sv[4] * rs * ws1[0], sv[5] * rs * ws1[1]); os.w = cvtpk(sv[6] * rs * ws1[2], sv[7] * rs * ws1[3]);
        *(GAS v4u*)(MIX + (size_t)m * 1024 + 8 * lane) = oa; *(GAS v4u*)(MIX + (size_t)m * 1024 + 512 + 8 * lane) = os;
    }
}
#ifndef MK_DUP
#define MK_DUP 0
#endif

__device__ __forceinline__ int f2key(unsigned bits) { const int s = (int)bits; return s ^ ((s >> 31) & 0x7fffffff); }
__device__ __forceinline__ int imax(int a, int b) { return a > b ? a : b; }
__device__ __forceinline__ int imin(int a, int b) { return a < b ? a : b; }
template <int OFF> __device__ __forceinline__ void sort16_desc(int (&v)[64]) {
#pragma unroll
    for (int k = 2; k <= 16; k <<= 1)
#pragma unroll
        for (int j = k >> 1; j > 0; j >>= 1)
#pragma unroll
            for (int i = 0; i < 16; ++i) { const int l = i ^ j;
                if (l > i) { const int x = v[OFF + i], y = v[OFF + l]; const int hi = imax(x, y), lo = imin(x, y);
                    if ((i & k) == 0) { v[OFF + i] = hi; v[OFF + l] = lo; } else { v[OFF + i] = lo; v[OFF + l] = hi; } } }
}
template <int OFF> __device__ __forceinline__ void bitonic_merge16_desc(int (&v)[64]) {
#pragma unroll
    for (int j = 8; j > 0; j >>= 1)
#pragma unroll
        for (int i = 0; i < 16; ++i) { const int l = i ^ j;
            if (l > i) { const int x = v[OFF + i], y = v[OFF + l]; v[OFF + i] = imax(x, y); v[OFF + l] = imin(x, y); } }
}
template <int A_, int B_> __device__ __forceinline__ void merge_top16(int (&v)[64]) {
#pragma unroll
    for (int i = 0; i < 16; ++i) v[A_ + i] = imax(v[A_ + i], v[B_ + 15 - i]);
    bitonic_merge16_desc<A_>(v);
}
__device__ __forceinline__ void top16_of_64(int (&v)[64]) {
    sort16_desc<0>(v); sort16_desc<16>(v); sort16_desc<32>(v); sort16_desc<48>(v);
    merge_top16<0, 16>(v); merge_top16<32, 48>(v); merge_top16<0, 32>(v);
}
__host__ __device__ constexpr int hyp_off(int i) { int o = 0; for (int k = 0; k < i; ++k) o += 16 / (k + 1); return o; }
static_assert(hyp_off(16) == 50, "50 candidates");
__device__ __forceinline__ int swap32_other_i(int x) {
    auto s = __builtin_amdgcn_permlane32_swap((unsigned)x, (unsigned)x, false, false);
    return (threadIdx.x & 32) ? (int)s[0] : (int)s[1];
}

__device__ __forceinline__ void route_tile(const Args& A, LAS unsigned char* stg, LAS unsigned char* kl8, LAS unsigned short* idxL, LAS float* gateL, size_t m0, int tl0, int h, int lane) {
    unsigned char* ws = A.ws;
    const unsigned short* SC = (const unsigned short*)(ws + WS_PQ);
    const int a = lane & 31, hh = lane >> 5;
    int top[2][16];
#pragma unroll
    for (int half = 0; half < 2; ++half) {
        v4u sr[8];
#pragma unroll
        for (int it = 0; it < 8; ++it) sr[it] = *(const GAS v4u*)(SC + (m0 + (lane >> 4) + 4 * it) * 2048 + h * 256 + half * 128 + (lane & 15) * 8);
#pragma unroll
        for (int it = 0; it < 8; ++it) { const int row = (lane >> 4) + 4 * it; *(LAS v4u*)(stg + row * 256 + 16 * ((lane & 15) ^ (row & 15))) = sr[it]; }
        asm volatile("s_waitcnt lgkmcnt(0)" ::: "memory");
        int v[64];
#pragma unroll
        for (int j = 0; j < 8; ++j) { const v4u d = *(const LAS v4u*)(stg + a * 256 + 16 * ((8 * hh + j) ^ (a & 15)));
#pragma unroll
            for (int i = 0; i < 4; ++i) { const unsigned key = 64 * hh + 8 * j + 2 * i;
                const float f0 = (float)__builtin_bit_cast(_Float16, (unsigned short)(d[i] & 0xffffu)), f1 = (float)__builtin_bit_cast(_Float16, (unsigned short)(d[i] >> 16));
                v[8 * j + 2 * i] = f2key((__float_as_uint(f0) & 0xffffff80u) | key); v[8 * j + 2 * i + 1] = f2key((__float_as_uint(f1) & 0xffffff80u) | (key + 1)); } }
        asm volatile("s_waitcnt lgkmcnt(0)" ::: "memory");
        top16_of_64(v);
#pragma unroll
        for (int i = 0; i < 16; ++i) v[16 + i] = swap32_other_i(v[i]);
        merge_top16<0, 16>(v);
#pragma unroll
        for (int i = 0; i < 16; ++i) top[half][i] = f2key((unsigned)v[i]);
    }
    LAS unsigned char* kl = kl8 + lane;
#pragma unroll
    for (int i = 0; i < 16; ++i) { kl[64 * i] = (unsigned char)((unsigned)top[0][i] & 0x7fu); kl[64 * (16 + i)] = (unsigned char)((unsigned)top[1][i] & 0x7fu); }
    int v[64];
#pragma unroll
    for (int i = 0; i < 64; ++i) v[i] = f2key(0xff800000u);
#pragma unroll
    for (int i = 0; i < 16; ++i)
#pragma unroll
        for (int j = 0; j < 16; ++j)
            if ((i + 1) * (j + 1) <= 16) {
                const float s = __uint_as_float((unsigned)top[0][i] & 0xffffff80u) + __uint_as_float((unsigned)top[1][j] & 0xffffff80u);
                v[hyp_off(i) + j] = f2key((__float_as_uint(s) & 0xffffff00u) | (unsigned)(i * 16 + j));
            }
    top16_of_64(v);
    float g[16]; float den = 0.f; const float b0 = __uint_as_float((unsigned)f2key((unsigned)v[0]) & 0xffffff00u);
#pragma unroll
    for (int r = 0; r < 16; ++r) { g[r] = __builtin_amdgcn_exp2f((__uint_as_float((unsigned)f2key((unsigned)v[r]) & 0xffffff00u) - b0) * LOG2E); den += g[r]; }
    const float inv = __builtin_amdgcn_rcpf(den);
#pragma unroll
    for (int r = 0; r < 16; ++r) {
        if ((r >> 3) == hh) {
            const unsigned ij = (unsigned)f2key((unsigned)v[r]) & 0xffu;
            const unsigned e = (unsigned)kl[64 * (ij >> 4)] * 128u + (unsigned)kl[64 * (16 + (ij & 15u))];
            idxL[((tl0 + a) * 16 + r) * 8 + h] = (unsigned short)e; gateL[((tl0 + a) * 16 + r) * 8 + h] = g[r] * inv;
#ifdef MK_WRITE_SEL
            { v2u o; o.x = e; o.y = __float_as_uint(g[r] * inv); *(GAS v2u*)((v2u*)(ws + WS_SEL) + (m0 + a) * 128 + h * 16 + r) = o; }
#endif
        }
    }
    asm volatile("s_waitcnt lgkmcnt(0)" ::: "memory");
}

constexpr size_t P7_SLICE_ELEMS = (size_t)16384 * 64;
__device__ __forceinline__ int sdot4_z(int a, int b) { int d; asm("v_dot4_i32_i8 %0, %1, %2, 0" : "=v"(d) : "v"(a), "v"(b)); return d; }
template <int PMODE = 0> __device__ __forceinline__ void p7_sliced(const Args& A, LAS unsigned char* lds, int vcu, int lane, int w, float* out, const XcdBarrier& bar) {
    unsigned char* ws = A.ws;
    const bf16* U = (const bf16*)(ws + WS_U); const bf16* V = (const bf16*)(ws + WS_V); const bf16* X1B = (const bf16*)(ws + WS_X1B);
    const float* rowsq = (const float*)(ws + WS_ROWSQ);
    const int g = lane >> 2, c = lane & 3;
    const size_t mbase = (size_t)vcu * 64 + w * 8;
    { LAS unsigned char* stg_ = lds + 49152 + w * 8192; LAS unsigned char* kl8_ = lds + 114688 + w * 2048;
      route_tile(A, stg_, kl8_, (LAS unsigned short*)lds, (LAS float*)(lds + 16384), (size_t)vcu * 64 + 32 * (w & 1), 32 * (w & 1), w >> 1, lane);
      route_tile(A, stg_, kl8_, (LAS unsigned short*)lds, (LAS float*)(lds + 16384), (size_t)vcu * 64 + 32 * (w & 1), 32 * (w & 1), (w >> 1) + 4, lane); }
    __syncthreads();
    LAS unsigned short* idxL = (LAS unsigned short*)(lds + w * 2048);
    LAS float* gateL = (LAS float*)(lds + 16384 + w * 4096);
    float rs[8];
#pragma unroll
    for (int tk = 0; tk < 8; ++tk) rs[tk] = rsqrtf(row16_sum(rowsq[(mbase + tk) * 16 + (lane & 15)]) * (1.0f / 1024.0f) + EPS);
    LAS signed char* x8 = (LAS signed char*)(lds + 49152 + w * 8192);
    float sxs[8];
#pragma unroll
    for (int tk = 0; tk < 8; ++tk) {
        const bf16* xr = X1B + (mbase + tk) * 1024 + 16 * lane;
        const v4u x0 = *(const GAS v4u*)xr, x1 = *(const GAS v4u*)(xr + 8);
        float f[16]; float am = 0.f;
#pragma unroll
        for (int i = 0; i < 4; ++i) { f[2 * i] = bf_lo(x0[i]); f[2 * i + 1] = bf_hi(x0[i]); f[8 + 2 * i] = bf_lo(x1[i]); f[8 + 2 * i + 1] = bf_hi(x1[i]); }
#pragma unroll
        for (int i = 0; i < 16; ++i) am = fmaxf(am, fabsf(f[i]));
#pragma unroll
        for (int o = 1; o < 64; o <<= 1) am = fmaxf(am, __shfl_xor(am, o));
        const float inv = am > 0.f ? 127.0f / am : 0.f;
        v4u o;
#pragma unroll
        for (int i = 0; i < 4; ++i) { const int q0 = (int)rintf(f[4 * i] * inv), q1 = (int)rintf(f[4 * i + 1] * inv), q2 = (int)rintf(f[4 * i + 2] * inv), q3 = (int)rintf(f[4 * i + 3] * inv);
            o[i] = (unsigned)(q0 & 0xff) | ((unsigned)(q1 & 0xff) << 8) | ((unsigned)(q2 & 0xff) << 16) | ((unsigned)(q3 & 0xff) << 24); }
        *(LAS v4u*)(x8 + tk * 1024 + 16 * lane) = o;
        sxs[tk] = am * (1.0f / 127.0f) * rs[tk];
    }
    int acc[8][8];
#pragma unroll
    for (int tk = 0; tk < 8; ++tk)
#pragma unroll
        for (int q = 0; q < 8; ++q) acc[tk][q] = 0;
    const unsigned c16 = 16u * (unsigned)c;
#define P7A_ISSUE(BUF, jj, s_) do { \
        const __amdgpu_buffer_rsrc_t rs_ = __builtin_amdgcn_make_buffer_rsrc((void*)(ws + WS_U + (size_t)(jj) * ((size_t)16384 * 128)), 0, 16384 * 128, 0x00020000);        \
        const unsigned idw_ = *(const LAS unsigned*)(idxL + (((s_) >> 2) * 16 + g) * 8 + 2 * ((s_) & 3)); \
        const int o0_ = (int)(((idw_ & 0xffffu) << 7) | c16), o1_ = (int)(((idw_ >> 16) << 7) | c16); \
        BUF[0] = __builtin_bit_cast(v4u, __builtin_amdgcn_raw_buffer_load_b128(rs_, o0_, 0, 0)); BUF[1] = __builtin_bit_cast(v4u, __builtin_amdgcn_raw_buffer_load_b128(rs_, o0_ + 64, 0, 0)); \
        BUF[2] = __builtin_bit_cast(v4u, __builtin_amdgcn_raw_buffer_load_b128(rs_, o1_, 0, 0)); BUF[3] = __builtin_bit_cast(v4u, __builtin_amdgcn_raw_buffer_load_b128(rs_, o1_ + 64, 0, 0)); } while (0)
#define P7A_MATH(BUF, XA, XB, s_) do { \
        _Pragma("unroll") for (int qq_ = 0; qq_ < 2; ++qq_) { int d_ = acc[(s_) >> 2][2 * ((s_) & 3) + qq_]; \
            _Pragma("unroll") for (int i_ = 0; i_ < 4; ++i_) { d_ = __builtin_amdgcn_sdot4((int)BUF[2 * qq_][i_], (int)XA[i_], d_, false); d_ = __builtin_amdgcn_sdot4((int)BUF[2 * qq_ + 1][i_], (int)XB[i_], d_, false); } \
            acc[(s_) >> 2][2 * ((s_) & 3) + qq_] = d_; } } while (0)
    {
        v4u b0[4], b1[4], b2[4], b3[4];
        if (!(PMODE & 2)) { P7A_ISSUE(b0, 0, 0); P7A_ISSUE(b1, 0, 1); P7A_ISSUE(b2, 0, 2); }
        for (int j = 0; j < ((PMODE & 2) ? 0 : 8); ++j) {
            const int jn = j < 7 ? j + 1 : 7;
#ifdef MK_P7_RESYNC
            if (PMODE == 0 && (j & (MK_P7_RESYNC - 1)) == 0 && j) xcd_barrier(bar);
#endif
#pragma unroll
            for (int tk = 0; tk < 8; ++tk) {
                const v4u xa = *(const LAS v4u*)(x8 + tk * 1024 + 128 * j + 16 * c), xb = *(const LAS v4u*)(x8 + tk * 1024 + 128 * j + 64 + 16 * c);
                P7A_ISSUE(b3, j, 4 * tk + 3); __builtin_amdgcn_sched_barrier(0);
                P7A_MATH(b0, xa, xb, 4 * tk + 0); __builtin_amdgcn_sched_barrier(0);
                if (tk < 7) P7A_ISSUE(b0, j, 4 * tk + 4); else P7A_ISSUE(b0, jn, 0);
                __builtin_amdgcn_sched_barrier(0);
                P7A_MATH(b1, xa, xb, 4 * tk + 1); __builtin_amdgcn_sched_barrier(0);
                if (tk < 7) P7A_ISSUE(b1, j, 4 * tk + 5); else P7A_ISSUE(b1, jn, 1);
                __builtin_amdgcn_sched_barrier(0);
                P7A_MATH(b2, xa, xb, 4 * tk + 2); __builtin_amdgcn_sched_barrier(0);
                if (tk < 7) P7A_ISSUE(b2, j, 4 * tk + 6); else P7A_ISSUE(b2, jn, 2);
                __builtin_amdgcn_sched_barrier(0);
                P7A_MATH(b3, xa, xb, 4 * tk + 3); __builtin_amdgcn_sched_barrier(0);
            }
        }
    }
#undef P7A_ISSUE
#undef P7A_MATH
    const float* SU = (const float*)(ws + WS_SU); const float* SV = (const float*)(ws + WS_SV);
    unsigned w4[8][2]; float sw[8];
#pragma unroll
    for (int tk = 0; tk < 8; ++tk) {
        const LAS f32x4* gp = (const LAS f32x4*)(gateL + (tk * 16 + g) * 8); const f32x4 g0 = gp[0], g1 = gp[1];
        const v4u id = *(const LAS v4u*)(idxL + (tk * 16 + g) * 8);
        float wq[8];
#pragma unroll
        for (int q = 0; q < 8; ++q) { int s = acc[tk][q]; s += __builtin_amdgcn_mov_dpp(s, 0xB1, 0xf, 0xf, true); s += __builtin_amdgcn_mov_dpp(s, 0x4E, 0xf, 0xf, true);
            const unsigned e = (id[q >> 1] >> (16 * (q & 1))) & 0xffffu;
            wq[q] = (q < 4 ? g0[q & 3] : g1[q & 3]) * gelu_tanh_f(sxs[tk] * SU[e] * (float)s) * SV[e]; }
        float am = 0.f;
#pragma unroll
        for (int q = 0; q < 8; ++q) am = fmaxf(am, fabsf(wq[q]));
#pragma unroll
        for (int o = 1; o < 64; o <<= 1) am = fmaxf(am, __shfl_xor(am, o));
        const float inv = am > 0.f ? 127.0f / am : 0.f; sw[tk] = am * (1.0f / 127.0f);
#pragma unroll
        for (int k = 0; k < 2; ++k) { const int q0 = (int)rintf(wq[4 * k] * inv), q1 = (int)rintf(wq[4 * k + 1] * inv), q2 = (int)rintf(wq[4 * k + 2] * inv), q3 = (int)rintf(wq[4 * k + 3] * inv);
            w4[tk][k] = (unsigned)(q0 & 0xff) | ((unsigned)(q1 & 0xff) << 8) | ((unsigned)(q2 & 0xff) << 16) | ((unsigned)(q3 & 0xff) << 24); }
    }
#define P7B_ISSUE(BUF, jj, s_) do { \
        const __amdgpu_buffer_rsrc_t rs_ = __builtin_amdgcn_make_buffer_rsrc((void*)(ws + WS_V + (size_t)(jj) * ((size_t)16384 * 128)), 0, 16384 * 128, 0x00020000); \
        const v2u id_ = *(const LAS v2u*)(idxL + (((s_) >> 1) * 16 + g) * 8 + 4 * ((s_) & 1)); \
        _Pragma("unroll") for (int qq_ = 0; qq_ < 4; ++qq_) { const unsigned e_ = (id_[qq_ >> 1] >> (16 * (qq_ & 1))) & 0xffffu; const int o_ = (int)((e_ << 7) | c16); \
            BUF[2 * qq_] = __builtin_bit_cast(v4u, __builtin_amdgcn_raw_buffer_load_b128(rs_, o_, 0, 0)); BUF[2 * qq_ + 1] = __builtin_bit_cast(v4u, __builtin_amdgcn_raw_buffer_load_b128(rs_, o_ + 64, 0, 0)); } } while (0)
#define P7B_MATH(BUF, s_) do { const int wq_ = (int)w4[(s_) >> 1][(s_) & 1]; if (PMODE & 8) { y[(s_) & 31] += (int)(BUF[0][0] ^ BUF[1][1] ^ BUF[2][2] ^ BUF[3][3] ^ BUF[4][0] ^ BUF[5][1] ^ BUF[6][2] ^ BUF[7][3]) & wq_; } else \
        _Pragma("unroll") for (int ch_ = 0; ch_ < 2; ++ch_) \
        _Pragma("unroll") for (int i_ = 0; i_ < 4; ++i_) { const unsigned a_ = BUF[0 + ch_][i_], b_ = BUF[2 + ch_][i_], c_ = BUF[4 + ch_][i_], d_ = BUF[6 + ch_][i_]; \
            const unsigned pl_ = __builtin_amdgcn_perm(b_, a_, 0x05010400u), ph_ = __builtin_amdgcn_perm(b_, a_, 0x07030602u), ql_ = __builtin_amdgcn_perm(d_, c_, 0x05010400u), qh_ = __builtin_amdgcn_perm(d_, c_, 0x07030602u); \
            y[16 * ch_ + 4 * i_ + 0] = ((s_) & 1) ? __builtin_amdgcn_sdot4((int)__builtin_amdgcn_perm(ql_, pl_, 0x05040100u), wq_, y[16 * ch_ + 4 * i_ + 0], false) : sdot4_z((int)__builtin_amdgcn_perm(ql_, pl_, 0x05040100u), wq_); \
            y[16 * ch_ + 4 * i_ + 1] = ((s_) & 1) ? __builtin_amdgcn_sdot4((int)__builtin_amdgcn_perm(ql_, pl_, 0x07060302u), wq_, y[16 * ch_ + 4 * i_ + 1], false) : sdot4_z((int)__builtin_amdgcn_perm(ql_, pl_, 0x07060302u), wq_); \
            y[16 * ch_ + 4 * i_ + 2] = ((s_) & 1) ? __builtin_amdgcn_sdot4((int)__builtin_amdgcn_perm(qh_, ph_, 0x05040100u), wq_, y[16 * ch_ + 4 * i_ + 2], false) : sdot4_z((int)__builtin_amdgcn_perm(qh_, ph_, 0x05040100u), wq_); \
            y[16 * ch_ + 4 * i_ + 3] = ((s_) & 1) ? __builtin_amdgcn_sdot4((int)__builtin_amdgcn_perm(qh_, ph_, 0x07060302u), wq_, y[16 * ch_ + 4 * i_ + 3], false) : sdot4_z((int)__builtin_amdgcn_perm(qh_, ph_, 0x07060302u), wq_); } } while (0)
    {
        v4u b0[8], b1[8], b2[8], b3[8];
#ifdef MK_X1_BF16
        const size_t eo_lane = (size_t)((g >> 3) * 64 + 16 * c + 2 * (g & 7));
        unsigned hi_nxt = 0u; if (!(PMODE & 1)) hi_nxt = __builtin_nontemporal_load((const GAS unsigned*)(X1B + mbase * 1024 + eo_lane));
#endif
        if (!(PMODE & 1)) { P7B_ISSUE(b0, 0, 0); P7B_ISSUE(b1, 0, 1); P7B_ISSUE(b2, 0, 2); }
        for (int j = 0; j < ((PMODE & 1) ? 0 : 8); ++j) {
            const int jn = j < 7 ? j + 1 : 7;
#ifdef MK_P7_RESYNC
            if (PMODE == 0 && (j & (MK_P7_RESYNC - 1)) == 0 && j) xcd_barrier(bar);
#endif
#pragma unroll
            for (int tp = 0; tp < 4; ++tp) {
#pragma unroll
                for (int half = 0; half < 2; ++half) {
                    const int tk = 2 * tp + half;
                    int y[32];
#pragma unroll
                    for (int i = 0; i < 32; ++i) y[i] = 0;
                    float* op = out + (mbase + tk) * 1024 + 128 * j + (g >> 3) * 64 + 16 * c + 2 * (g & 7);
#ifdef MK_HILO
                    unsigned hi_raw = 0u; (void)hi_raw;
                    f32x2_t ov = {0.f, 0.f}; if (!(PMODE & 16)) { const size_t eo_ = (mbase + tk) * 1024 + 128 * j + (g >> 3) * 64 + 16 * c + 2 * (g & 7);
#ifdef MK_X1_BF16
                        (void)eo_; hi_raw = hi_nxt; const size_t en_ = tk < 7 ? (mbase + tk + 1) * 1024 + 128 * j + eo_lane : mbase * 1024 + 128 * jn + eo_lane;
                        hi_nxt = __builtin_nontemporal_load((const GAS unsigned*)(X1B + en_)); }
#else
                        const unsigned hi_ = *(const GAS unsigned*)(X1B + eo_), lo_ = *(const GAS unsigned*)(x1lo_ptr(ws, mbase + tk) + (eo_ & 1023));
                        ov = (f32x2_t){bf_lo(hi_) + bf_lo(lo_), bf_hi(hi_) + bf_hi(lo_)}; }
#endif
#else
                    f32x2_t ov = {0.f, 0.f}; if (!(PMODE & 16)) ov = *(const GAS f32x2_t*)op;
#endif
                    if (half == 0) {
                        P7B_ISSUE(b3, j, 4 * tp + 3); __builtin_amdgcn_sched_barrier(0);
                        P7B_MATH(b0, 4 * tp + 0); __builtin_amdgcn_sched_barrier(0);
                        if (tp < 3) P7B_ISSUE(b0, j, 4 * tp + 4); else P7B_ISSUE(b0, jn, 0);
                        __builtin_amdgcn_sched_barrier(0);
                        P7B_MATH(b1, 4 * tp + 1); __builtin_amdgcn_sched_barrier(0);
                    } else {
                        if (tp < 3) P7B_ISSUE(b1, j, 4 * tp + 5); else P7B_ISSUE(b1, jn, 1);
                        __builtin_amdgcn_sched_barrier(0);
                        P7B_MATH(b2, 4 * tp + 2); __builtin_amdgcn_sched_barrier(0);
                        if (tp < 3) P7B_ISSUE(b2, j, 4 * tp + 6); else P7B_ISSUE(b2, jn, 2);
                        __builtin_amdgcn_sched_barrier(0);
                        P7B_MATH(b3, 4 * tp + 3); __builtin_amdgcn_sched_barrier(0);
                    }
                    int z[16];
#pragma unroll
                    for (int k = 0; k < 16; ++k) { if (PMODE & 4) { z[k] = y[k] + y[16 + k]; } else { auto r = __builtin_amdgcn_permlane32_swap((unsigned)y[k], (unsigned)y[16 + k], false, false); z[k] = (int)r[0] + (int)r[1]; } }
                    int z2[8];
#pragma unroll
                    for (int k = 0; k < 8; ++k) { if (PMODE & 4) { z2[k] = z[k] + z[8 + k]; } else { auto r = __builtin_amdgcn_permlane16_swap((unsigned)z[k], (unsigned)z[8 + k], false, false); z2[k] = (int)r[0] + (int)r[1]; } }
                    int z3[4];
#pragma unroll
                    for (int k = 0; k < 4; ++k) { const int keep = (lane & 8) ? z2[4 + k] : z2[k], send = (lane & 8) ? z2[k] : z2[4 + k]; z3[k] = keep + __builtin_amdgcn_mov_dpp(send, 0x128, 0xf, 0xf, true); }
                    int z4[2];
#pragma unroll
                    for (int k = 0; k < 2; ++k) { const int keep = (lane & 4) ? z3[2 + k] : z3[k], send = (lane & 4) ? z3[k] : z3[2 + k];
                        z4[k] = keep + __builtin_amdgcn_mov_dpp(__builtin_amdgcn_mov_dpp(send, 0x1B, 0xf, 0xf, true), 0x141, 0xf, 0xf, true); }
#ifdef MK_X1_BF16
                    ov = (f32x2_t){bf_lo(hi_raw), bf_hi(hi_raw)};
#endif
                    f32x2_t res; res.x = ov.x + sw[tk] * (float)z4[0]; res.y = ov.y + sw[tk] * (float)z4[1];
                    if (!(PMODE & 16) || res.x == 12345.678f) __builtin_nontemporal_store(res, (GAS f32x2_t*)op);
                    __builtin_amdgcn_sched_barrier(0);
                }
            }
        }
    }
#undef P7B_ISSUE
#undef P7B_MATH
}

__global__ void __launch_bounds__(NWAVES * 64, 2) mega_fwd(Args args) {
    extern __shared__ __attribute__((aligned(16))) unsigned char lds_raw[];
    LAS unsigned char* lds = (LAS unsigned char*)lds_raw;
    volatile LAS unsigned* MISC = (volatile LAS unsigned*)(lds + MISC_OFF);
    const int tid = threadIdx.x, lane = tid & 63, wave = __builtin_amdgcn_readfirstlane(tid >> 6);
    const int G = gridDim.x; const int bx = blockIdx.x; const int vcu = (G % 8 == 0) ? (bx % 8) * (G / 8) + bx / 8 : bx;
    const int gw = vcu * NWAVES + wave, NGW = G * NWAVES;
    unsigned char* ws = args.ws;
    gu32* ctl = (gu32*)(ws + WS_CTL);
    for (int u = tid; u < (LDS_BYTES - LDSCTL_OFF) / 4; u += NWAVES * 64) ((LAS unsigned*)(lds + LDSCTL_OFF))[u] = 0u;
    __syncthreads();
    XcdBarrier bar = xcd_barrier_post((unsigned*)(ctl + CW_BAR), MISC + 8);
    const int lo = args.ph_lo, hi = args.ph_hi;
#define IN(k) (lo <= (k) && (k) < hi)
#define BOTH(k) (IN(k) && IN((k) + 1))
#define GRID_BAR() xcd_barrier(bar)

#ifdef MK_STAMP
    unsigned long long ts_[9]; ts_[0] = __builtin_amdgcn_s_memrealtime();
#define STAMP(k) ts_[(k) + 1] = __builtin_amdgcn_s_memrealtime()
#else
#define STAMP(k) do {} while (0)
#endif
#ifndef MK_DUP
#define MK_DUP 0
#endif
    if (IN(0)) { p0_prologue(args, lds, gw, NGW, wave, lane); for (int u = vcu; u < 256; u += G) p0_wf_unit(args, lds, u, tid, lane, wave); if (BOTH(0)) GRID_BAR(); } STAMP(0);

#ifndef MK_TBL_PRE
#define MK_TBL_PRE 0
#endif
constexpr int TBL_PRE = MK_TBL_PRE;
constexpr int TBL_SPLIT = 13312;
#define PH_GEMM1 \
    if (IN(1)) {    \
        pg8::Gemm g{(const bf16*)(ws + WS_H), (const bf16*)(ws + WS_WIN), T, 2560, 1024}; pg8::StaticOrder S; S.init(T, 2560, G, bx); \
        pg8::EpiProj E{(bf16*)(ws + WS_Q), (bf16*)(ws + WS_K), (bf16*)(ws + WS_VV), (bf16*)(ws + WS_UA), (bf16*)(ws + WS_VA), args.in[3], args.in[4]}; \
        if (G == 256 && bx >= 128) p0_tables(args, 0, TBL_PRE, (bx - 128) * NWAVES + wave, 128 * NWAVES, lane);     \
        pg8::gemm_phase<pg8::EpiProj, pg8::StaticOrder, true, true>(lds + RING_OFF, g, S, E); \
        if (G == 256) { if (bx >= 128) p0_tables(args, TBL_PRE, TBL_SPLIT, (bx - 128) * NWAVES + wave, 128 * NWAVES, lane); else p0_tables(args, TBL_SPLIT, 16384, bx * NWAVES + wave, 128 * NWAVES, lane); } else p0_tables(args, 0, 16384, gw, NGW, lane); \
        if (BOTH(1)) GRID_BAR(); \
    }
#if (MK_DUP & 2)
    PH_GEMM1
#endif
    PH_GEMM1 STAMP(1);
    if (IN(2)) {
        if (G == 256) {
          AttnStage st; const int xb = vcu >> 5, r = vcu & 31;
#define AU_OF(k) ((((k) % 3) << 9) + xb * 64 + (4 * ((k) / 3) + (r >> 3)) * 8 + (r & 7))
          attn_issue(args, AU_OF(0), tid, st); attn_issue_q(args, AU_OF(0), tid, st);
          for (int k = 0; k < 6; ++k) {
              const int u = AU_OF(k);
              attn_commit<true>(args, lds, u, tid, st);
              __syncthreads();
              if (k + 1 < 6) attn_issue(args, AU_OF(k + 1), tid, st);
              attn_compute<0, true>(args, lds, u, tid, lane, wave, k + 1 < 6 ? AU_OF(k + 1) : -1, &st);
              __syncthreads();
          }
#undef AU_OF
          for (int k = 0; k < 2; ++k) sgu_unit(args, lds, xb * 64 + r + 32 * k, tid, lane, wave);
        } else { AttnStage st; int u = vcu;
          if (u < 1536) attn_issue(args, u, tid, st);
          for (; u < 1536; u += G) {
              attn_commit(args, lds, u, tid, st);
              __syncthreads();
              if (u + G < 1536) attn_issue(args, u + G, tid, st);
              attn_compute(args, lds, u, tid, lane, wave);
              __syncthreads();
          }
          for (; u < 2048; u += G) sgu_unit(args, lds, u - 1536, tid, lane, wave); }
        if (BOTH(2)) GRID_BAR();
    } STAMP(2);
    if (IN(3)) {
        if (G == 256) p3_merge(args, (vcu >> 5) * SEQ + (vcu & 31) * NWAVES + wave, ((vcu >> 5) + 1) * SEQ, 32 * NWAVES, lane); else p3_merge(args, gw, T, NGW, lane);
        if (BOTH(3)) GRID_BAR(); } STAMP(3);
#define PH_GEMM2 \
    if (IN(4)) {    \
        pg8::Gemm g{(const bf16*)(ws + WS_H), (const bf16*)(ws + WS_WOUT), T, 1024, 1024}; pg8::StaticOrder S; S.init(T, 1024, G, bx); \
        pg8::EpiOut E{args.in[0], args.out, (bf16*)(ws + WS_X1B), (float*)(ws + WS_ROWSQ), (bf16*)(ws + WS_X1LO_A), (bf16*)(ws + WS_X1LO_B)}; \
        pg8::gemm_phase<pg8::EpiOut, pg8::StaticOrder, true, true>(lds + RING_OFF, g, S, E); \
        if (BOTH(4)) GRID_BAR(); \
    }
#if (MK_DUP & 16)
    PH_GEMM2
#endif
    PH_GEMM2 STAMP(4);
#ifdef MK_G3DELAY
#define G3DELAY if (bx >= 128) { for (int q_ = 0; q_ < MK_G3DELAY; ++q_) __builtin_amdgcn_s_sleep(127); }
#else
#define G3DELAY
#endif
#define PH_GEMM3 \
    if (IN(5)) {    \
        pg8::Gemm g{(const bf16*)(ws + WS_X1B), (const bf16*)(ws + WS_WQ), T, 2048, 1024}; pg8::StaticOrder S; S.init(T, 2048, G, bx); \
        pg8::EpiPQ E{(const float*)(ws + WS_ROWSQ), (bf16*)(ws + WS_PQ)}; \
        G3DELAY \
        pg8::gemm_phase<pg8::EpiPQ, pg8::StaticOrder, true, true>(lds + RING_OFF, g, S, E); \
        if (BOTH(5)) GRID_BAR(); \
    }
#if (MK_DUP & 32)
    PH_GEMM3
#endif
    PH_GEMM3 STAMP(5);
    STAMP(6);
#if (MK_DUP & 128)
    if (IN(7)) { if (vcu < T / 64) p7_sliced<0>(args, lds, vcu, lane, wave, (float*)(ws + WS_PQ), bar); GRID_BAR(); }
#endif
    if (IN(7)) { if (vcu < T / 64) p7_sliced<0>(args, lds, vcu, lane, wave, args.out, bar); } STAMP(7);
#ifdef MK_STAMP
    if (gw == 0 && lane == 0) { asm volatile("s_waitcnt vmcnt(0)" ::: "memory"); args.out[0] += (float)(ts_[MK_STAMP + 1] - ts_[MK_STAMP]) * 0.01f; }
#endif
#ifdef MK_PROBE_PHASES
#ifndef MK_RT_VARIANT
#define MK_RT_VARIANT 0
#endif
    if (IN(10)) { if (vcu < T / 64) p7_sliced<MK_RT_VARIANT>(args, lds, vcu, lane, wave, (float*)(ws + WS_PQ), bar); }
    if (IN(12)) { p0_prologue(args, lds, gw, NGW, wave, lane); }
    if (IN(13)) { p3_merge(args, gw, T, NGW, lane); }
    if (IN(14)) { for (int u = vcu; u < 512; u += G) sgu_unit(args, lds, u, tid, lane, wave); }
#endif
#undef IN
#undef BOTH
#undef GRID_BAR
}

#ifndef MK_CUTS
#define MK_CUTS 0
#endif
static void mega_launch(void* const* d_in, void* d_out, void* d_ws, hipStream_t stream, int ph_lo, int ph_hi, bool cuts) {
    static int grid = 0;
    if (grid == 0) {
        int dev = 0, cus = 0, per_cu = 0;
        if (hipGetDevice(&dev) != hipSuccess || hipDeviceGetAttribute(&cus, hipDeviceAttributeMultiprocessorCount, dev) != hipSuccess) { fprintf(stderr, "kernel_launch: device query failed\n"); grid = -1; return; }
        if (hipFuncSetAttribute((const void*)mega_fwd, hipFuncAttributeMaxDynamicSharedMemorySize, LDS_BYTES) != hipSuccess) { fprintf(stderr, "kernel_launch: hipFuncSetAttribute failed\n"); grid = -1; return; }
        if (hipOccupancyMaxActiveBlocksPerMultiprocessor(&per_cu, (const void*)mega_fwd, NWAVES * 64, LDS_BYTES) != hipSuccess || per_cu < 1) fprintf(stderr, "kernel_launch: occupancy query reports %d\n", per_cu);
        (void)hipGetLastError();
        grid = cus;
    }
    if (grid < 0) return;
    Args a{};
    for (int i = 0; i < 17; ++i) a.in[i] = (const float*)d_in[i];
    a.out = (float*)d_out; a.ws = (unsigned char*)d_ws;
    if (!cuts) { (void)hipMemsetAsync((char*)d_ws + WS_CTL, 0, CTL_ZERO_BYTES, stream); a.ph_lo = ph_lo; a.ph_hi = ph_hi; hipLaunchKernelGGL(mega_fwd, dim3(grid), dim3(NWAVES * 64), LDS_BYTES, stream, a); }
    else for (int p = ph_lo; p < ph_hi; ++p) { (void)hipMemsetAsync((char*)d_ws + WS_CTL, 0, CTL_ZERO_BYTES, stream); a.ph_lo = p; a.ph_hi = p + 1; hipLaunchKernelGGL(mega_fwd, dim3(grid), dim3(NWAVES * 64), LDS_BYTES, stream, a); }
    const hipError_t le = hipPeekAtLastError();
    if (le != hipSuccess) fprintf(stderr, "kernel_launch: launch failed: %s\n", hipGetErrorName(le));
}

extern "C" void kernel_launch(void* const* d_in, const int* in_sizes, int n_in, void* d_out, int out_size, void* d_ws, size_t ws_size, hipStream_t stream) {
    mega_launch(d_in, d_out, d_ws, stream, 0, 8, MK_CUTS != 0);
}
```

```cpp
#define MK_TBL_PRE 5120
#define MK_HILO 1
#define MK_X1_BF16 1
#define MK_P7_LSYNC 641
#include <hip/hip_runtime.h>
#include <cstdio>
#include <cstdint>
#include <cmath>
namespace pg8 {
#define PG8_LAS __attribute__((address_space(3)))
typedef unsigned short bf16_t;
typedef short bf16x8 __attribute__((ext_vector_type(8)));
typedef float f32x4 __attribute__((ext_vector_type(4)));
typedef unsigned u32x4 __attribute__((ext_vector_type(4)));
constexpr int BM = 256, BK = 64, HALF = 128, HTB = HALF * BK * 2  , STAGE_BYTES = 8 * HTB, NXCD = 8, WGM = 8;

__host__ __device__ __forceinline__ int lds_byte(int r, int c) { const int st = (r >> 4) * 2 + (c >> 5), rr = r & 15, cc = c & 31, ob = rr * 64 + cc * 2; return st * 1024 + (ob ^ (((ob >> 9) & 1) << 5)); }
__host__ __device__ __forceinline__ void stage_rc(int b, int& R, int& C) { const int st = b / 1024, sb = b % 1024, swz = sb ^ (((sb >> 9) & 1) << 5); R = (st >> 1) * 16 + swz / 64; C = (st & 1) * 32 + (swz % 64) / 2; }
__host__ __device__ __forceinline__ int perm32(int rho) { const int n = rho >> 4, i = rho & 15; return 8 * (i >> 2) + 4 * n + (i & 3); }

struct Unit { int pm, pn; };
struct Gemm { const bf16_t* A; const bf16_t* Bt; int M, N, K; };

struct StaticOrder {
    int nM, nN, nwg, G, c;
    __host__ __device__ void init(int M, int N, int G_, int c_) { nM = M / BM; nN = N / BM; nwg = nM * nN; G = G_; c = c_; }
    __host__ __device__ bool next(int i, Unit& u) const {
        const long L = (long)i * G + c; if (L >= nwg) return false;
        int wgid = (int)L; { const int q = nwg / NXCD, r = nwg % NXCD, xcd = wgid % NXCD, off = wgid / NXCD; wgid = (xcd < r ? xcd * (q + 1) : r * (q + 1) + (xcd - r) * q) + off; }
        const int nig = WGM * nN, gid = wgid / nig, fm = gid * WGM, gsz = (nM - fm) < WGM ? (nM - fm) : WGM;
        u.pm = fm + ((wgid % nig) % gsz); u.pn = (wgid % nig) / gsz; return true;
    }
    __device__ __forceinline__ void a_ready(const Unit&) const {}
    __device__ __forceinline__ void done(const Unit&) const {}
};


typedef float f32x2_t __attribute__((ext_vector_type(2))); typedef __bf16 bf16x2_t __attribute__((ext_vector_type(2)));
__device__ __forceinline__ unsigned cvtpk(float lo, float hi) { f32x2_t v = {lo, hi}; bf16x2_t b = __builtin_convertvector(v, bf16x2_t); return __builtin_bit_cast(unsigned, b); }
__device__ __forceinline__ float gelu_tanh_f(float x) {
    const float u2 = x * (1.5957691216057308f + 0.07135481627260025f * x * x);
    return x * __builtin_amdgcn_rcpf(1.0f + __builtin_amdgcn_exp2f(-1.4426950408889634f * u2));
}
__device__ __forceinline__ unsigned cvtpk_h(float lo, float hi) { typedef _Float16 h2_t __attribute__((ext_vector_type(2))); f32x2_t v = {lo, hi}; h2_t b = __builtin_convertvector(v, h2_t); return __builtin_bit_cast(unsigned, b); }
__device__ __forceinline__ float xsum_16_32(float x) {
    auto s = __builtin_amdgcn_permlane16_swap(__float_as_uint(x), __float_as_uint(x), false, false); x = __uint_as_float(s[0]) + __uint_as_float(s[1]);
    auto t = __builtin_amdgcn_permlane32_swap(__float_as_uint(x), __float_as_uint(x), false, false); return __uint_as_float(t[0]) + __uint_as_float(t[1]);
}
constexpr float QSCALE = 0.125f * 1.4426950408889634f;
constexpr float RMS_EPS = 1e-6f;

struct EpiProj {
    static constexpr bool PERM = true, AFTER_DRAIN = false;
    bf16_t *Q, *K, *V, *UA, *VA; const float *qw, *kw;
    __device__ __forceinline__ void operator()(const f32x4 (&acc)[2][2][4][2], const Unit& u, int wr, int wc, int fr, int fq) const {
        const int kind = u.pn >> 1;
        const int cin = (u.pn & 1) * 256 + wc * 64;
        bf16_t* dst = kind == 0 ? Q : kind == 1 ? K : kind == 2 ? V : kind == 3 ? UA : VA;
        f32x4 wv[2][2];
        if (kind < 2) { const float* w = kind == 0 ? qw : kw;
#pragma unroll
            for (int bj = 0; bj < 2; ++bj)
#pragma unroll
                for (int n = 0; n < 2; ++n) wv[bj][n] = *(const f32x4*)(w + 32 * bj + 8 * fq + 4 * n); }
#pragma unroll
        for (int ai = 0; ai < 2; ++ai)
#pragma unroll
            for (int m = 0; m < 4; ++m) {
                const int row = u.pm * BM + ai * HALF + wr * 64 + m * 16 + fr;
                f32x4 v[2][2];
#pragma unroll
                for (int bj = 0; bj < 2; ++bj)
#pragma unroll
                    for (int n = 0; n < 2; ++n) v[bj][n] = acc[ai][bj][m][n];
                if (kind < 2) {
                    float ss = 0.f;
#pragma unroll
                    for (int bj = 0; bj < 2; ++bj)
#pragma unroll
                        for (int n = 0; n < 2; ++n) { const f32x4 x = v[bj][n]; ss += (x[0] * x[0] + x[1] * x[1]) + (x[2] * x[2] + x[3] * x[3]); }
                    ss = xsum_16_32(ss);
                    const float r = rsqrtf(ss * (1.0f / 64.0f) + RMS_EPS) * (kind == 0 ? QSCALE : 1.0f);
#pragma unroll
                    for (int bj = 0; bj < 2; ++bj)
#pragma unroll
                        for (int n = 0; n < 2; ++n) v[bj][n] = v[bj][n] * r * wv[bj][n];
                } else if (kind >= 3) {
#pragma unroll
                    for (int bj = 0; bj < 2; ++bj)
#pragma unroll
                        for (int n = 0; n < 2; ++n)
#pragma unroll
                            for (int i = 0; i < 4; ++i) v[bj][n][i] = gelu_tanh_f(v[bj][n][i]);
                }
                bf16_t* rowp = dst + (size_t)row * 512 + cin + 8 * fq;
#pragma unroll
                for (int bj = 0; bj < 2; ++bj) { u32x4 w; w.x = cvtpk(v[bj][0][0], v[bj][0][1]); w.y = cvtpk(v[bj][0][2], v[bj][0][3]); w.z = cvtpk(v[bj][1][0], v[bj][1][1]); w.w = cvtpk(v[bj][1][2], v[bj][1][3]);
                    *(u32x4*)(rowp + 32 * bj) = w; }
            }
    }
};

struct EpiOut {
    static constexpr bool PERM = true, AFTER_DRAIN = false;
    const float* x; float* out; bf16_t* X1B; float* rowsq; bf16_t* loA; bf16_t* loB;
    __device__ __forceinline__ void operator()(const f32x4 (&acc)[2][2][4][2], const Unit& u, int wr, int wc, int fr, int fq) const {
        const int col0 = u.pn * BM + wc * 64 + 8 * fq;
#pragma unroll
        for (int ai = 0; ai < 2; ++ai)
#pragma unroll
            for (int m = 0; m < 4; ++m) {
                const int row = u.pm * BM + ai * HALF + wr * 64 + m * 16 + fr; const size_t off = (size_t)row * 1024 + col0;
                float ss = 0.f;
#pragma unroll
                for (int bj = 0; bj < 2; ++bj) {
                    const f32x4 r0 = *(const f32x4*)(x + off + 32 * bj), r1 = *(const f32x4*)(x + off + 32 * bj + 4);
                    const f32x4 a = acc[ai][bj][m][0] + r0, b = acc[ai][bj][m][1] + r1;
                    ss += (a[0] * a[0] + a[1] * a[1]) + (a[2] * a[2] + a[3] * a[3]) + (b[0] * b[0] + b[1] * b[1]) + (b[2] * b[2] + b[3] * b[3]);
                    u32x4 w; w.x = cvtpk(a[0], a[1]); w.y = cvtpk(a[2], a[3]); w.z = cvtpk(b[0], b[1]); w.w = cvtpk(b[2], b[3]);
                    *(u32x4*)(X1B + off + 32 * bj) = w;
#if defined(MK_HILO) && !defined(MK_X1_BF16)
                    u32x4 l;
                    l.x = cvtpk(a[0] - __uint_as_float(w.x << 16), a[1] - __uint_as_float(w.x & 0xffff0000u)); l.y = cvtpk(a[2] - __uint_as_float(w.y << 16), a[3] - __uint_as_float(w.y & 0xffff0000u));
                    l.z = cvtpk(b[0] - __uint_as_float(w.z << 16), b[1] - __uint_as_float(w.z & 0xffff0000u)); l.w = cvtpk(b[2] - __uint_as_float(w.w << 16), b[3] - __uint_as_float(w.w & 0xffff0000u));
                    bf16_t* lop = row < 8192 ? loA + off : loB + (off - (size_t)8192 * 1024);
                    *(u32x4*)(lop + 32 * bj) = l;
#elif defined(MK_X1_BF16)
#else
                    *(f32x4*)(out + off + 32 * bj) = a; *(f32x4*)(out + off + 32 * bj + 4) = b;
#endif
                }
                ss = xsum_16_32(ss);
                if (fq == 0) rowsq[(size_t)row * 16 + u.pn * 4 + wc] = ss;
            }
    }
};

struct EpiPQ {
    static constexpr bool PERM = true, AFTER_DRAIN = false;
    const float* rowsq; bf16_t* PQ;
    __device__ __forceinline__ void operator()(const f32x4 (&acc)[2][2][4][2], const Unit& u, int wr, int wc, int fr, int fq) const {
        const int col0 = u.pn * BM + wc * 64 + 8 * fq;
#pragma unroll
        for (int ai = 0; ai < 2; ++ai)
#pragma unroll
            for (int m = 0; m < 4; ++m) {
                const int row = u.pm * BM + ai * HALF + wr * 64 + m * 16 + fr;
                const f32x4* rq = (const f32x4*)(rowsq + (size_t)row * 16);
                const f32x4 s0 = rq[0], s1 = rq[1], s2 = rq[2], s3 = rq[3];
                const float ss = ((s0[0] + s0[1]) + (s0[2] + s0[3])) + ((s1[0] + s1[1]) + (s1[2] + s1[3])) + ((s2[0] + s2[1]) + (s2[2] + s2[3])) + ((s3[0] + s3[1]) + (s3[2] + s3[3]));
                const float r = rsqrtf(ss * (1.0f / 1024.0f) + RMS_EPS);
                bf16_t* rowp = PQ + (size_t)row * 2048 + col0;
#pragma unroll
                for (int bj = 0; bj < 2; ++bj) { const f32x4 a = acc[ai][bj][m][0] * r, b = acc[ai][bj][m][1] * r;
                    u32x4 w; w.x = cvtpk_h(a[0], a[1]); w.y = cvtpk_h(a[2], a[3]); w.z = cvtpk_h(b[0], b[1]); w.w = cvtpk_h(b[2], b[3]);
                    *(u32x4*)(rowp + 32 * bj) = w; }
            }
    }
};

template <class Epi, class Sched, bool ALIGN_EPI = false, bool SP2 = false>
__device__ __forceinline__ void gemm_phase(PG8_LAS unsigned char* lds, const Gemm g, const Sched& S, const Epi& E) {
    const int tid = threadIdx.x, wid = __builtin_amdgcn_readfirstlane(tid >> 6), lane = tid & 63, wr = wid >> 2, wc = wid & 3, fr = lane & 15, fq = lane >> 4;
    const int K = g.K, nt = K / BK;
    unsigned voffA[2], voffB[2];
#pragma unroll
    for (int i = 0; i < 2; ++i) { int R, C; stage_rc(tid * 16 + i * 8192, R, C); const int Rb = Epi::PERM ? ((R & ~31) + perm32(R & 31)) : R;
        voffA[i] = (unsigned)(R * K + C) * 2u; voffB[i] = (unsigned)(Rb * K + C) * 2u; }
    const size_t kstep = (size_t)(BK * 2);
    const size_t hstep = (size_t)HALF * K * 2;
    const size_t tstep = 2 * hstep;
    const unsigned ldsw = (unsigned)wid * 1024u;
    const int aoff = lds_byte(wr * 64 + fr, fq * 8), boff = lds_byte(wc * 32 + fr, fq * 8);
#define PG8_SA(b, h) (((b) * 2 + (h)) * HTB)
#define PG8_SB(b, h) ((4 + (b) * 2 + (h)) * HTB)
#define PG8_STAGE(bufoff, gbase, voff) do { _Pragma("unroll") for (int _i = 0; _i < 2; ++_i) \
        __builtin_amdgcn_global_load_lds((const unsigned*)((const char*)(gbase) + (voff)[_i]), (PG8_LAS unsigned*)(lds + (bufoff) + ldsw + _i * 8192), 16, 0, 0); } while (0)
#define PG8_LDA(dst, b, h) do { _Pragma("unroll") for (int m = 0; m < 4; ++m) _Pragma("unroll") for (int k = 0; k < 2; ++k) dst[m][k] = *(const PG8_LAS bf16x8*)(lds + PG8_SA(b, h) + aoff + m * 2048 + k * 1024); } while (0)
#define PG8_LDB(dst, b, h) do { _Pragma("unroll") for (int n = 0; n < 2; ++n) _Pragma("unroll") for (int k = 0; k < 2; ++k) dst[n][k] = *(const PG8_LAS bf16x8*)(lds + PG8_SB(b, h) + boff + n * 2048 + k * 1024); } while (0)
#define PG8_MMA(ai, bj, At, Bt) do { __builtin_amdgcn_s_setprio(1); _Pragma("unroll") for (int m = 0; m < 4; ++m) _Pragma("unroll") for (int n = 0; n < 2; ++n) _Pragma("unroll") for (int k = 0; k < 2; ++k) \
        acc[ai][bj][m][n] = __builtin_amdgcn_mfma_f32_16x16x32_bf16(Bt[n][k], At[m][k], acc[ai][bj][m][n], 0, 0, 0); __builtin_amdgcn_s_setprio(0); } while (0)
#define PG8_WAIT_V(n) asm volatile("s_waitcnt vmcnt(" #n ")" ::: "memory")
#define PG8_WAIT_L(n) asm volatile("s_waitcnt lgkmcnt(" #n ")" ::: "memory")
#define PG8_BAR __builtin_amdgcn_s_barrier()
#define PG8_SCHED __builtin_amdgcn_sched_barrier(0)
    Unit cur, nxt; int ui = 0;
    if (!S.next(0, cur)) return;
    f32x4 acc[2][2][4][2];
#pragma unroll
    for (int a = 0; a < 2; ++a)
#pragma unroll
        for (int b = 0; b < 2; ++b)
#pragma unroll
            for (int m = 0; m < 4; ++m)
#pragma unroll
                for (int n = 0; n < 2; ++n) acc[a][b][m][n] = (f32x4){0.f, 0.f, 0.f, 0.f};
    bf16x8 At[4][2], B0[2][2], B1[2][2];
    const char* cA = (const char*)g.A + (size_t)cur.pm * tstep; const char* cB = (const char*)g.Bt + (size_t)cur.pn * tstep;
    S.a_ready(cur);
    if constexpr (SP2) {
        PG8_STAGE(PG8_SB(0, 0), cB, voffB); PG8_STAGE(PG8_SB(0, 1), cB + hstep, voffB); PG8_STAGE(PG8_SA(0, 0), cA, voffA); PG8_STAGE(PG8_SA(0, 1), cA + hstep, voffA);
        if (wr == 1) PG8_BAR;
        PG8_WAIT_V(2); PG8_BAR;
        PG8_STAGE(PG8_SB(1, 0), cB + kstep, voffB); PG8_STAGE(PG8_SA(1, 0), cA + kstep, voffA); PG8_STAGE(PG8_SB(1, 1), cB + hstep + kstep, voffB);
        PG8_WAIT_V(6); PG8_BAR;
    } else {
        PG8_STAGE(PG8_SB(0, 0), cB, voffB); PG8_STAGE(PG8_SA(0, 0), cA, voffA); PG8_STAGE(PG8_SB(0, 1), cB + hstep, voffB); PG8_STAGE(PG8_SA(0, 1), cA + hstep, voffA);
        if (wr == 1) PG8_BAR;
        PG8_WAIT_V(4); PG8_BAR;
        PG8_STAGE(PG8_SB(1, 0), cB + kstep, voffB); PG8_STAGE(PG8_SA(1, 0), cA + kstep, voffA); PG8_STAGE(PG8_SB(1, 1), cB + hstep + kstep, voffB);
        PG8_WAIT_V(6); PG8_BAR;
    }
    for (;;) {
        const bool has_next = S.next(ui + 1, nxt);
        const char* nA = has_next ? (const char*)g.A + (size_t)nxt.pm * tstep : cA; const char* nB = has_next ? (const char*)g.Bt + (size_t)nxt.pn * tstep : cB;
        for (int t = 0; t < nt; t += 2) {
            const bool last = (t == nt - 2);
            const char* a1 = cA + (size_t)(t + 1) * kstep;
            const char* a2 = last ? nA : cA + (size_t)(t + 2) * kstep; const char* b2 = last ? nB : cB + (size_t)(t + 2) * kstep;
            const char* a3 = a2 + kstep; const char* b3 = b2 + kstep;
            if (last && has_next) S.a_ready(nxt);
            if constexpr (SP2) {
            PG8_LDB(B0, 0, 0); PG8_LDB(B1, 0, 1); PG8_SCHED; PG8_LDA(At, 0, 0); PG8_STAGE(PG8_SA(1, 1), a1 + hstep, voffA);
            PG8_WAIT_V(8); PG8_WAIT_L(0); PG8_BAR; PG8_MMA(0, 0, At, B0); PG8_MMA(0, 1, At, B1); PG8_BAR; PG8_SCHED;
            PG8_LDA(At, 0, 1); PG8_STAGE(PG8_SB(0, 0), b2, voffB); PG8_STAGE(PG8_SB(0, 1), b2 + hstep, voffB); PG8_STAGE(PG8_SA(0, 0), a2, voffA);
            PG8_WAIT_V(8); PG8_WAIT_L(0); PG8_BAR; PG8_MMA(1, 0, At, B0); PG8_MMA(1, 1, At, B1); PG8_BAR; PG8_SCHED;
            PG8_LDB(B0, 1, 0); PG8_LDB(B1, 1, 1); PG8_SCHED; PG8_LDA(At, 1, 0); PG8_STAGE(PG8_SA(0, 1), a2 + hstep, voffA);
            PG8_WAIT_V(8); PG8_WAIT_L(0); PG8_BAR; PG8_MMA(0, 0, At, B0); PG8_MMA(0, 1, At, B1); PG8_BAR; PG8_SCHED;
            PG8_LDA(At, 1, 1); PG8_STAGE(PG8_SB(1, 0), b3, voffB); PG8_STAGE(PG8_SB(1, 1), b3 + hstep, voffB); PG8_STAGE(PG8_SA(1, 0), a3, voffA);
            PG8_WAIT_V(8); PG8_WAIT_L(0); PG8_BAR; PG8_MMA(1, 0, At, B0); PG8_MMA(1, 1, At, B1); PG8_BAR; PG8_SCHED;
            } else {
            PG8_LDB(B0, 0, 0); PG8_SCHED; PG8_LDA(At, 0, 0); PG8_STAGE(PG8_SA(1, 1), a1 + hstep, voffA);
            PG8_WAIT_L(8); PG8_BAR; PG8_WAIT_L(0); PG8_MMA(0, 0, At, B0); PG8_BAR; PG8_SCHED;
            PG8_LDB(B1, 0, 1); PG8_STAGE(PG8_SB(0, 0), b2, voffB);
            PG8_BAR; PG8_WAIT_L(0); PG8_MMA(0, 1, At, B1); PG8_BAR;
            PG8_LDA(At, 0, 1); PG8_STAGE(PG8_SA(0, 0), a2, voffA);
            PG8_BAR; PG8_WAIT_L(0); PG8_MMA(1, 0, At, B0); PG8_BAR; PG8_SCHED;
            PG8_STAGE(PG8_SB(0, 1), b2 + hstep, voffB);
            PG8_WAIT_V(6); PG8_BAR; PG8_MMA(1, 1, At, B1); PG8_BAR;
            PG8_LDB(B0, 1, 0); PG8_SCHED; PG8_LDA(At, 1, 0); PG8_STAGE(PG8_SA(0, 1), a2 + hstep, voffA);
            PG8_WAIT_L(8); PG8_BAR; PG8_WAIT_L(0); PG8_MMA(0, 0, At, B0); PG8_BAR; PG8_SCHED;
            PG8_LDB(B1, 1, 1); PG8_STAGE(PG8_SB(1, 0), b3, voffB);
            PG8_BAR; PG8_WAIT_L(0); PG8_MMA(0, 1, At, B1); PG8_BAR;
            PG8_LDA(At, 1, 1); PG8_STAGE(PG8_SA(1, 0), a3, voffA);
            PG8_BAR; PG8_WAIT_L(0); PG8_MMA(1, 0, At, B0); PG8_BAR; PG8_SCHED;
            PG8_STAGE(PG8_SB(1, 1), b3 + hstep, voffB);
            PG8_WAIT_V(6); PG8_BAR; PG8_MMA(1, 1, At, B1); PG8_BAR;
            }
        }
        if constexpr (ALIGN_EPI) { if (wr == 0) PG8_BAR; }
        if constexpr (!Epi::AFTER_DRAIN) { E(acc, cur, wr, wc, fr, fq); S.done(cur); }
        if (!has_next) break;
#pragma unroll
        for (int a = 0; a < 2; ++a)
#pragma unroll
            for (int b = 0; b < 2; ++b)
#pragma unroll
                for (int m = 0; m < 4; ++m)
#pragma unroll
                    for (int n = 0; n < 2; ++n) acc[a][b][m][n] = (f32x4){0.f, 0.f, 0.f, 0.f};
        cur = nxt; cA = nA; cB = nB; ++ui;
        if constexpr (ALIGN_EPI) { if (wr == 1) PG8_BAR; }
    }
    PG8_WAIT_V(0);
    if constexpr (!ALIGN_EPI) { if (wr == 0) PG8_BAR; }
    PG8_BAR;
    if constexpr (Epi::AFTER_DRAIN) { E.fused(acc, cur, wr, wc, fr, fq, lds, wid, lane); S.done(cur); }
#undef PG8_SA
#undef PG8_SB
#undef PG8_STAGE
#undef PG8_LDA
#undef PG8_LDB
#undef PG8_MMA
#undef PG8_WAIT_V
#undef PG8_WAIT_L
#undef PG8_BAR
#undef PG8_SCHED
}
}

constexpr int NWAVES = 8;
constexpr int T = 16384, DM = 1024, SEQ = 2048;
constexpr float EPS = 1e-6f;
constexpr float LOG2E = 1.4426950408889634f;

constexpr size_t MiB = 1u << 20;
constexpr size_t WS_CTL = 0, CTL_ZERO_BYTES = 1 * MiB;
constexpr size_t WS_BIAS = 1 * MiB;
constexpr size_t WS_KEYS = 1 * MiB + 64 * 1024;
constexpr size_t WS_WIN = 2 * MiB, WS_WOUT = 7 * MiB, WS_WQ = 9 * MiB;
constexpr size_t WS_ROWSQ = 13 * MiB;
constexpr size_t WS_U = 16 * MiB, WS_V = 48 * MiB;
constexpr size_t WS_SU = 32 * MiB, WS_SV = 33 * MiB;
constexpr size_t WS_H = 80 * MiB;
constexpr size_t WS_Q = 112 * MiB, WS_K = 128 * MiB, WS_VV = 144 * MiB;
constexpr size_t WS_X1B = 112 * MiB;
constexpr size_t WS_UA = 160 * MiB, WS_VA = 176 * MiB;
constexpr size_t WS_OP = 192 * MiB;
constexpr size_t WS_LSE = 240 * MiB;
constexpr size_t WS_PQ = 160 * MiB;
constexpr size_t WS_SEL = 80 * MiB;
constexpr size_t WS_X1LO_A = 144 * MiB, WS_X1LO_B = 224 * MiB;
constexpr size_t WS_END = 242 * MiB;
constexpr int CW_GRP = 8192, CW_GGEN = 9216;
constexpr int CW_BAR = 4096;

constexpr int RING_OFF = 0, RING_BYTES = 131072;
constexpr int LDSCTL_OFF = RING_BYTES, MISC_OFF = LDSCTL_OFF + 320;
constexpr int LDS_BYTES = 147456;

#define GAS __attribute__((address_space(1)))
#define LAS __attribute__((address_space(3)))
typedef unsigned short bf16;
typedef unsigned v4u __attribute__((ext_vector_type(4)));
typedef unsigned v2u __attribute__((ext_vector_type(2)));
typedef float f32x4 __attribute__((ext_vector_type(4)));
typedef float f32x16 __attribute__((ext_vector_type(16)));
typedef short bf16x8 __attribute__((ext_vector_type(8)));
typedef short s16x4 __attribute__((ext_vector_type(4)));
typedef short v4i16_t __attribute__((ext_vector_type(4)));
typedef __bf16 bf16x2 __attribute__((ext_vector_type(2)));
typedef GAS unsigned gu32;
#define RLX_AGENT __ATOMIC_RELAXED, __HIP_MEMORY_SCOPE_AGENT
#define LDS_WAIT() asm volatile("s_waitcnt lgkmcnt(0)" ::: "memory")
using pg8::cvtpk; using pg8::gelu_tanh_f; using pg8::f32x2_t;
__device__ __forceinline__ float bf_lo(unsigned w) { return __uint_as_float(w << 16); }
__device__ __forceinline__ float bf_hi(unsigned w) { return __uint_as_float(w & 0xffff0000u); }
__device__ __forceinline__ float dot2_bf16(unsigned w, unsigned x, float acc) { return __builtin_amdgcn_fdot2_f32_bf16(__builtin_bit_cast(bf16x2, w), __builtin_bit_cast(bf16x2, x), acc, false); }
template <int CTRL> __device__ __forceinline__ float dpp(float x) { return __builtin_bit_cast(float, __builtin_amdgcn_mov_dpp(__builtin_bit_cast(int, x), CTRL, 0xf, 0xf, true)); }
__device__ __forceinline__ float swap32_other(float x) {
    auto s = __builtin_amdgcn_permlane32_swap(__float_as_uint(x), __float_as_uint(x), false, false);
    return (threadIdx.x & 32) ? __uint_as_float(s[0]) : __uint_as_float(s[1]);
}
__device__ __forceinline__ float row16_sum(float x) {
    x += dpp<0xB1>(x); x += dpp<0x4E>(x); x += dpp<0x141>(x); x += dpp<0x128>(x); return x;
}
__device__ __forceinline__ float wave_sum(float x) {
    x = row16_sum(x);
    auto s = __builtin_amdgcn_permlane16_swap(__float_as_uint(x), __float_as_uint(x), false, false);
    x = __uint_as_float(s[0]) + __uint_as_float(s[1]);
    auto t = __builtin_amdgcn_permlane32_swap(__float_as_uint(x), __float_as_uint(x), false, false);
    return __uint_as_float(t[0]) + __uint_as_float(t[1]);
}
__device__ __forceinline__ float wave_max(float x) {
    x = fmaxf(x, dpp<0xB1>(x)); x = fmaxf(x, dpp<0x4E>(x)); x = fmaxf(x, dpp<0x141>(x)); x = fmaxf(x, dpp<0x128>(x));
    auto s = __builtin_amdgcn_permlane16_swap(__float_as_uint(x), __float_as_uint(x), false, false);
    x = fmaxf(__uint_as_float(s[0]), __uint_as_float(s[1]));
    auto t = __builtin_amdgcn_permlane32_swap(__float_as_uint(x), __float_as_uint(x), false, false);
    return fmaxf(__uint_as_float(t[0]), __uint_as_float(t[1]));
}
__device__ __forceinline__ unsigned pack_i8x4(f32x4 v, float scale) {
    unsigned w = 0u;
    w = __builtin_amdgcn_cvt_pk_u8_f32(__builtin_fmaf(v.x, scale, 128.0f), 0u, w); w = __builtin_amdgcn_cvt_pk_u8_f32(__builtin_fmaf(v.y, scale, 128.0f), 1u, w);
    w = __builtin_amdgcn_cvt_pk_u8_f32(__builtin_fmaf(v.z, scale, 128.0f), 2u, w); w = __builtin_amdgcn_cvt_pk_u8_f32(__builtin_fmaf(v.w, scale, 128.0f), 3u, w);
    return w ^ 0x80808080u;
}
__device__ __forceinline__ s16x4 vtr(const LAS unsigned char* p) { return __builtin_bit_cast(s16x4, __builtin_amdgcn_ds_read_tr16_b64_v4i16((LAS v4i16_t*)p)); }
__device__ __forceinline__ const bf16* x1lo_ptr(const unsigned char* ws, size_t row) { return row < 8192 ? (const bf16*)(ws + WS_X1LO_A) + row * 1024 : (const bf16*)(ws + WS_X1LO_B) + (row - 8192) * 1024; }
__device__ __forceinline__ int crow(int r, int hi) { return (r & 3) + 8 * (r >> 2) + 4 * hi; }
#define XB_TMO      128
#define XB_XCNT(j)  (256  + 64 * (j))
#define XB_XSUB(j)  (1280 + 64 * (j))
#define XB_XGEN(j)  (2304 + 64 * (j))
#define XB_TOP      3328
#define XB_TOPGEN   3392
#define XCD_BAR_WORDS 3456
#define XB_SPIN_CAP (1u << 18)

__device__ __forceinline__ unsigned xb_ld(unsigned* p)              { return __hip_atomic_load(p, __ATOMIC_RELAXED, __HIP_MEMORY_SCOPE_AGENT); }
__device__ __forceinline__ unsigned xb_add(unsigned* p, unsigned v) { return __hip_atomic_fetch_add(p, v, __ATOMIC_RELAXED, __HIP_MEMORY_SCOPE_AGENT); }
__device__ __forceinline__ unsigned xb_xcc_id() { return (unsigned)__builtin_amdgcn_s_getreg((3 << 11) | 20) & 0xFu; }
#define XB_SPIN(cond, bar) do { unsigned _sp = 0; while (cond) { __builtin_amdgcn_s_sleep(1); \
    if ((++_sp & 255u) == 0u) { if (xb_ld(&(bar)[XB_TMO])) break; if (_sp > XB_SPIN_CAP) { atomicAdd(&(bar)[XB_TMO], 1u); break; } } } } while (0)

struct XcdBarrier {
    unsigned* bar; unsigned x;
    volatile LAS unsigned* st;
};

__device__ __forceinline__ XcdBarrier xcd_barrier_post(unsigned* bar, volatile LAS unsigned* st) {
    XcdBarrier b; b.bar = bar; b.x = xb_xcc_id(); b.st = st;
    if (threadIdx.x == 0) (void)xb_add(&bar[XB_XCNT(b.x)], 1u);
    return b;
}
__device__ __forceinline__ void xcd_barrier_complete(unsigned* bar, unsigned x, unsigned& nloc, unsigned& nx) {
    const unsigned G = gridDim.x * gridDim.y * gridDim.z;
    unsigned sum, cnt, mine, sp = 0u;
    for (;;) {
        sum = 0u; cnt = 0u; mine = 0u;
#pragma unroll
        for (unsigned j = 0; j < 16; ++j) { const unsigned c = xb_ld(&bar[XB_XCNT(j)]); sum += c; cnt += (c > 0u) ? 1u : 0u; mine = (j == x) ? c : mine; }
        if (sum == G) break;
        __builtin_amdgcn_s_sleep(1);
        if ((++sp & 255u) == 0u) { if (xb_ld(&bar[XB_TMO])) break; if (sp > XB_SPIN_CAP) { atomicAdd(&bar[XB_TMO], 1u); break; } }
    }
    nloc = mine > 0u ? mine : 1u; nx = cnt > 0u ? cnt : 1u;
}

__device__ __forceinline__ void xcd_barrier(const XcdBarrier& b) {
    asm volatile("s_waitcnt vmcnt(0)" ::: "memory");
    __syncthreads();
    if (threadIdx.x == 0) {
        unsigned* bar = b.bar;
        __builtin_amdgcn_s_waitcnt(0);
        unsigned nloc = b.st[0], nx = b.st[1];
        if (nloc == 0u) { xcd_barrier_complete(bar, b.x, nloc, nx); b.st[0] = nloc; b.st[1] = nx; }
        const unsigned old = xb_add(&bar[XB_XSUB(b.x)], 1u);
        const unsigned gen = old / nloc;
        if (old + 1u == (gen + 1u) * nloc) {
            __builtin_amdgcn_fence(__ATOMIC_RELEASE, "agent");
            asm volatile("s_waitcnt vmcnt(0)" ::: "memory");
            const unsigned og = xb_add(&bar[XB_TOP], 1u);
            const unsigned tg = og / nx;
            if (og + 1u == (tg + 1u) * nx) xb_add(&bar[XB_TOPGEN], 1u);
            else XB_SPIN(xb_ld(&bar[XB_TOPGEN]) == tg, bar);
            __builtin_amdgcn_fence(__ATOMIC_ACQUIRE, "agent");
            xb_add(&bar[XB_XGEN(b.x)], 1u);
            asm volatile("s_waitcnt vmcnt(0)" ::: "memory");
        } else {
            XB_SPIN(xb_ld(&bar[XB_XGEN(b.x)]) == gen, bar);
            __builtin_amdgcn_fence(__ATOMIC_ACQUIRE, "agent");
            asm volatile("s_waitcnt vmcnt(0)" ::: "memory");
        }
    }
    __syncthreads();
}

struct Args { const float* in[17]; float* out; unsigned char* ws; int ph_lo, ph_hi; };

__device__ __forceinline__ void p0_transpose_item(const float* W, int K, int N, bf16* WT, LAS float* scr, int item, int lane, const float* kscale) {
    const int nblk = N / 32, kb = item / nblk, nb = item % nblk, k0 = 64 * kb, n0 = 32 * nb;
    const int r0 = (n0 & ~255) + 128 * ((n0 >> 5) & 1) + 32 * ((n0 >> 6) & 3);
#pragma unroll 8
    for (int i = 0; i < 32; ++i) { const int kk = 2 * i + (lane >> 5); float v = W[(size_t)(k0 + kk) * N + n0 + (lane & 31)]; if (kscale) v *= kscale[k0 + kk]; scr[kk * 33 + (lane & 31)] = v; }
    LDS_WAIT(); asm volatile("" ::: "memory");
    const int c = lane & 7;
#pragma unroll
    for (int j = 0; j < 4; ++j) { const int n = (lane >> 3) + 8 * j; const LAS float* s = scr + (8 * c) * 33 + n;
        v4u o; o.x = cvtpk(s[0 * 33], s[1 * 33]); o.y = cvtpk(s[2 * 33], s[3 * 33]); o.z = cvtpk(s[4 * 33], s[5 * 33]); o.w = cvtpk(s[6 * 33], s[7 * 33]);
        *(GAS v4u*)(WT + (size_t)(r0 + n) * K + k0 + 8 * c) = o; }
    LDS_WAIT(); asm volatile("" ::: "memory");
}
__device__ __forceinline__ int t5_bucket(int dist) {
    if (dist < 16) return dist;
    const float v = logf((float)dist / 16.0f) / 4.852030263919617f * 16.0f;
    const int l = 16 + (int)v;
    return l < 31 ? l : 31;
}
__device__ __forceinline__ void p0_tables(const Args& A, int row_lo, int row_hi, int gw, int NGW, int lane) {
    unsigned char* ws = A.ws; const float* ln2 = A.in[10];
    { const float* pu = A.in[14]; const float* pv = A.in[15]; signed char* U8 = (signed char*)(ws + WS_U); unsigned char* V8 = (unsigned char*)(ws + WS_V);
      float* SU = (float*)(ws + WS_SU); float* SV = (float*)(ws + WS_SV);
      f32x4 lw[4];
#pragma unroll
      for (int i = 0; i < 4; ++i) lw[i] = *(const f32x4*)(ln2 + 16 * lane + 4 * i);
#define TBL_LOAD(e_, u_, v_) do { const GAS f32x4* ur_ = (const GAS f32x4*)(pu + (size_t)(e_) * 1024 + 16 * lane); const GAS f32x4* vr_ = (const GAS f32x4*)(pv + (size_t)(e_) * 1024 + 16 * lane); \
        _Pragma("unroll") for (int i = 0; i < 4; ++i) { u_[i] = ur_[i]; v_[i] = vr_[i]; } } while (0)
#define TBL_ROW(e_, u_, v_) do { float am = 0.f, bm = 0.f; \
        _Pragma("unroll") for (int i = 0; i < 4; ++i) { u_[i] = u_[i] * lw[i]; \
            am = fmaxf(am, fmaxf(fmaxf(fabsf(u_[i].x), fabsf(u_[i].y)), fmaxf(fabsf(u_[i].z), fabsf(u_[i].w)))); \
            bm = fmaxf(bm, fmaxf(fmaxf(fabsf(v_[i].x), fabsf(v_[i].y)), fmaxf(fabsf(v_[i].z), fabsf(v_[i].w)))); } \
        am = wave_max(am); bm = wave_max(bm); \
        const float ia = am > 0.f ? 127.0f / am : 0.f, ib = bm > 0.f ? 127.0f / bm : 0.f; \
        v4u ou, ov; \
        _Pragma("unroll") for (int i = 0; i < 4; ++i) { ou[i] = pack_i8x4(u_[i], ia); ov[i] = pack_i8x4(v_[i], ib); } \
        const size_t dst = ((size_t)(lane >> 3) * 16384 + (e_)) * 128 + (lane & 7) * 16; \
        *(GAS v4u*)(U8 + dst) = ou; *(GAS v4u*)(V8 + dst) = ov; \
        if (lane == 0) { SU[e_] = am > 0.f ? am * (1.0f / 127.0f) : 1.0f; SV[e_] = bm * (1.0f / 127.0f); } } while (0)
      { f32x4 u[4], v[4], u2[4], v2[4], u3[4], v3[4], u4[4], v4[4];
        int e = row_lo + gw;
        if (e < row_hi) TBL_LOAD(e, u, v);
        if (e + NGW < row_hi) TBL_LOAD(e + NGW, u2, v2);
        for (; e < row_hi; e += 4 * NGW) {
            const int eq = e + 2 * NGW;
            if (eq < row_hi) TBL_LOAD(eq, u3, v3);
            if (eq + NGW < row_hi) TBL_LOAD(eq + NGW, u4, v4);
            __builtin_amdgcn_sched_barrier(0);
            TBL_ROW(e, u, v);
            if (e + NGW < row_hi) TBL_ROW(e + NGW, u2, v2);
            __builtin_amdgcn_sched_barrier(0);
            const int ep = e + 4 * NGW;
            if (ep < row_hi) TBL_LOAD(ep, u, v);
            if (ep + NGW < row_hi) TBL_LOAD(ep + NGW, u2, v2);
            __builtin_amdgcn_sched_barrier(0);
            if (eq < row_hi) TBL_ROW(eq, u3, v3);
            if (eq + NGW < row_hi) TBL_ROW(eq + NGW, u4, v4);
            __builtin_amdgcn_sched_barrier(0);
        } }
#undef TBL_LOAD
#undef TBL_ROW
      }
}
constexpr int WF_LD = 132;
constexpr int WF_W = 0, WF_K = 64 * WF_LD * 4;
__device__ __forceinline__ void p0_wf_unit(const Args& A, LAS unsigned char* lds, int u, int tid, int lane, int w) {
    const float* wq = A.in[11]; const float* ln2 = A.in[10];
    const int kt = u >> 4, hh16 = u & 15, h = hh16 >> 1, half = hh16 & 1, k0 = 64 * kt, c0 = h * 256 + half * 128;
    const float* keys = (half ? A.in[13] : A.in[12]) + (size_t)h * 128 * 128;
    LAS float* Wt = (LAS float*)(lds + WF_W); LAS float* Kt = (LAS float*)(lds + WF_K);
    __syncthreads();
    { f32x4 wv[4], kv[8];
#pragma unroll
      for (int it = 0; it < 4; ++it) { const int i = tid + 512 * it, r = i >> 5, d4 = i & 31; wv[it] = *(const f32x4*)(wq + (size_t)(k0 + r) * 2048 + c0 + 4 * d4); }
#pragma unroll
      for (int it = 0; it < 8; ++it) { const int i = tid + 512 * it; kv[it] = *(const f32x4*)(keys + 4 * i); }
#pragma unroll
      for (int it = 0; it < 4; ++it) { const int i = tid + 512 * it, r = i >> 5, d4 = i & 31; *(LAS f32x4*)(Wt + r * WF_LD + 4 * d4) = wv[it] * ln2[k0 + r]; }
#pragma unroll
      for (int it = 0; it < 8; ++it) { const int i = tid + 512 * it, r = i >> 5, d4 = i & 31; *(LAS f32x4*)(Kt + r * WF_LD + 4 * d4) = kv[it]; } }
    __syncthreads();
    const int mt = w >> 1, nt = w & 1, a = lane & 31, hh = lane >> 5;
    f32x16 acc;
#pragma unroll
    for (int r = 0; r < 16; ++r) acc[r] = 0.f;
    const LAS float* ap = Kt + (32 * mt + a) * WF_LD + hh; const LAS float* bp = Wt + (32 * nt + a) * WF_LD + hh;
#pragma unroll 8
    for (int s = 0; s < 64; ++s) acc = __builtin_amdgcn_mfma_f32_32x32x2f32(ap[2 * s], bp[2 * s], acc, 0, 0, 0);
    bf16* WT = (bf16*)(A.ws + WS_WQ);
#pragma unroll
    for (int r = 0; r < 16; ++r) { const int key = 32 * mt + crow(r, hh); const int n = c0 + key;
        const int row = (n & ~255) + 128 * ((n >> 5) & 1) + 32 * ((n >> 6) & 3) + (n & 31);
        WT[(size_t)row * 1024 + k0 + 32 * nt + a] = (bf16)(cvtpk(acc[r], 0.f) & 0xffffu); }
}
__device__ __forceinline__ void p0_prologue(const Args& A, LAS unsigned char* lds, int gw, int NGW, int wave, int lane) {
    unsigned char* ws = A.ws;
    LAS float* scr = (LAS float*)(lds + RING_OFF + wave * 16384);
    const float* w_in = A.in[2]; const float* w_out = A.in[9]; const float* w_q = A.in[11]; const float* ln2 = A.in[10];
    constexpr int I_IN = (1024 / 64) * (2560 / 32), I_OUT = (1024 / 64) * (1024 / 32), I_Q = (1024 / 64) * (2048 / 32);
    for (int it = gw; it < I_IN + I_OUT; it += NGW) {
        int r = it;
        if (r < I_IN) { p0_transpose_item(w_in, 1024, 2560, (bf16*)(ws + WS_WIN), scr, r, lane, nullptr); continue; } r -= I_IN;
        p0_transpose_item(w_out, 1024, 1024, (bf16*)(ws + WS_WOUT), scr, r, lane, nullptr);
    }
    { const float* x = A.in[0]; const float* ln1 = A.in[1]; bf16* H = (bf16*)(ws + WS_H);
      f32x4 wv[4];
#pragma unroll
      for (int j = 0; j < 4; ++j) wv[j] = *((const f32x4*)ln1 + lane + 64 * j);
      for (int m = gw; m < T; m += NGW) {
        const GAS f32x4* xr = (const GAS f32x4*)(x + (size_t)m * DM) + lane;
        f32x4 v[4]; float s = 0.f;
#pragma unroll
        for (int j = 0; j < 4; ++j) { v[j] = xr[64 * j]; s += (v[j].x * v[j].x + v[j].y * v[j].y) + (v[j].z * v[j].z + v[j].w * v[j].w); }
        const float r = rsqrtf(wave_sum(s) * (1.f / DM) + EPS);
        GAS v2u* o8 = (GAS v2u*)(H + (size_t)m * DM) + lane;
#pragma unroll
        for (int j = 0; j < 4; ++j) { const f32x4 y = v[j] * r * wv[j]; v2u o; o.x = cvtpk(y.x, y.y); o.y = cvtpk(y.z, y.w); o8[64 * j] = o; }
      } }
    { const float* rb = A.in[16]; float* BT = (float*)(ws + WS_BIAS);
      for (int i = gw * 64 + lane; i < 3 * 8 * 192; i += NGW * 64) {
        const int x = i % 192, h = (i / 192) & 7, p = i / (192 * 8); const int rel = 159 - x; const int dil = p == 0 ? 1 : (p == 1 ? 4 : 16);
        BT[i] = (rel >= 0 && rel <= 128) ? LOG2E * rb[t5_bucket(rel * dil) * 8 + h] : 0.f;
      } }
}

__device__ __forceinline__ void p0_fused(const Args& A, LAS unsigned char* lds, int u, int gw, int NGW, int tid, int wave, int lane) {
    unsigned char* ws = A.ws;
    const float* wq = A.in[11]; const float* ln2 = A.in[10];
    const int kt = u >> 4, hh16 = u & 15, h = hh16 >> 1, half = hh16 & 1, k0 = 64 * kt, c0 = h * 256 + half * 128;
    const float* keys = (half ? A.in[13] : A.in[12]) + (size_t)h * 128 * 128;
    f32x4 wvq[4], kv[8];
#pragma unroll
    for (int it = 0; it < 4; ++it) { const int i = tid + 512 * it, r = i >> 5, d4 = i & 31; wvq[it] = *(const f32x4*)(wq + (size_t)(k0 + r) * 2048 + c0 + 4 * d4); }
#pragma unroll
    for (int it = 0; it < 8; ++it) { const int i = tid + 512 * it; kv[it] = *(const f32x4*)(keys + 4 * i); }
    { LAS float* scr = (LAS float*)(lds + RING_OFF + wave * 16384);
      const float* w_in = A.in[2]; const float* w_out = A.in[9];
      constexpr int I_IN = (1024 / 64) * (2560 / 32), I_OUT = (1024 / 64) * (1024 / 32);
      for (int it = gw; it < I_IN + I_OUT; it += NGW) {
        int r = it;
        if (r < I_IN) { p0_transpose_item(w_in, 1024, 2560, (bf16*)(ws + WS_WIN), scr, r, lane, nullptr); continue; } r -= I_IN;
        p0_transpose_item(w_out, 1024, 1024, (bf16*)(ws + WS_WOUT), scr, r, lane, nullptr);
      } }
    __syncthreads();
    LAS float* Wt = (LAS float*)(lds + WF_W); LAS float* Kt = (LAS float*)(lds + WF_K);
#pragma unroll
    for (int it = 0; it < 4; ++it) { const int i = tid + 512 * it, r = i >> 5, d4 = i & 31; *(LAS f32x4*)(Wt + r * WF_LD + 4 * d4) = wvq[it] * ln2[k0 + r]; }
#pragma unroll
    for (int it = 0; it < 8; ++it) { const int i = tid + 512 * it, r = i >> 5, d4 = i & 31; *(LAS f32x4*)(Kt + r * WF_LD + 4 * d4) = kv[it]; }
    __syncthreads();
    const int mt = wave >> 1, nt = wave & 1, a = lane & 31, hh = lane >> 5;
    f32x16 acc;
#pragma unroll
    for (int r = 0; r < 16; ++r) acc[r] = 0.f;
    const LAS float* ap = Kt + (32 * mt + a) * WF_LD + hh; const LAS float* bp = Wt + (32 * nt + a) * WF_LD + hh;
    { const float* x = A.in[0]; const float* ln1 = A.in[1]; bf16* H = (bf16*)(ws + WS_H);
      f32x4 wv[4];
#pragma unroll
      for (int j = 0; j < 4; ++j) wv[j] = *((const f32x4*)ln1 + lane + 64 * j);
#pragma unroll
      for (int i8 = 0; i8 < 8; ++i8) {
        const int m = gw + i8 * NGW;
        const GAS f32x4* xr = (const GAS f32x4*)(x + (size_t)m * DM) + lane;
        f32x4 v[4]; float s = 0.f;
#pragma unroll
        for (int j = 0; j < 4; ++j) v[j] = xr[64 * j];
        __builtin_amdgcn_sched_barrier(0);
#pragma unroll
        for (int s8 = 0; s8 < 8; ++s8) { const int sk = 8 * i8 + s8; acc = __builtin_amdgcn_mfma_f32_32x32x2f32(ap[2 * sk], bp[2 * sk], acc, 0, 0, 0); }
        __builtin_amdgcn_sched_barrier(0);
#pragma unroll
        for (int j = 0; j < 4; ++j) s += (v[j].x * v[j].x + v[j].y * v[j].y) + (v[j].z * v[j].z + v[j].w * v[j].w);
        const float r = rsqrtf(wave_sum(s) * (1.f / DM) + EPS);
        GAS v2u* o8 = (GAS v2u*)(H + (size_t)m * DM) + lane;
#pragma unroll
        for (int j = 0; j < 4; ++j) { const f32x4 y = v[j] * r * wv[j]; v2u o; o.x = cvtpk(y.x, y.y); o.y = cvtpk(y.z, y.w); o8[64 * j] = o; }
      } }
    { bf16* WT = (bf16*)(ws + WS_WQ);
#pragma unroll
      for (int r = 0; r < 16; ++r) { const int key = 32 * mt + crow(r, hh); const int n = c0 + key;
        const int row = (n & ~255) + 128 * ((n >> 5) & 1) + 32 * ((n >> 6) & 3) + (n & 31);
        WT[(size_t)row * 1024 + k0 + 32 * nt + a] = (bf16)(cvtpk(acc[r], 0.f) & 0xffffu); } }
    { const float* rb = A.in[16]; float* BT = (float*)(ws + WS_BIAS);
      for (int i = gw * 64 + lane; i < 3 * 8 * 192; i += NGW * 64) {
        const int x = i % 192, hb = (i / 192) & 7, p = i / (192 * 8); const int rel = 159 - x; const int dil = p == 0 ? 1 : (p == 1 ? 4 : 16);
        BT[i] = (rel >= 0 && rel <= 128) ? LOG2E * rb[t5_bucket(rel * dil) * 8 + hb] : 0.f;
      } }
}

constexpr int AT_K = 0, AT_V = 49152, AT_Q = 98304, AT_BT = 131072 + 1024;
constexpr float NEGBIG = -1e30f;
struct AttnStage { v4u kr[6], vr[6], qr[4]; float bt; };
__device__ __forceinline__ void attn_decode(int au, int& p, int& b, int& h, int& dil, int& res0, int& i0) {
    p = au >> 9; const int idx = au & 511; b = idx >> 6; h = (idx >> 3) & 7; const int sub = idx & 7;
    if (p == 0) { dil = 1; res0 = 0; i0 = sub * 256; } else if (p == 1) { dil = 4; res0 = sub >> 1; i0 = (sub & 1) * 256; } else { dil = 16; res0 = sub * 2; i0 = 0; }
}
__device__ __forceinline__ void attn_issue(const Args& A, int au, int tid, AttnStage& st) {
    unsigned char* ws = A.ws;
    asm volatile("" : "+v"(tid));
    const bf16* Kg = (const bf16*)(ws + WS_K); const bf16* Vg = (const bf16*)(ws + WS_VV);
    int p, b, h, dil, res0, i0; attn_decode(au, p, b, h, dil, res0, i0);
    const size_t tokbase = (size_t)b * SEQ; const int c = tid & 7;
#pragma unroll
    for (int it = 0; it < 6; ++it) { const int R = (tid >> 3) + 64 * it; int tok; bool ok;
        if (p < 2) { const int ki = i0 - 128 + R; ok = ki >= 0; tok = res0 + dil * ki; } else { ok = R < 256; tok = res0 + (R >> 7) + 16 * (R & 127); }
        if (ok) { const size_t off = (tokbase + tok) * 512 + h * 64 + c * 8; st.kr[it] = *(const GAS v4u*)(Kg + off); st.vr[it] = *(const GAS v4u*)(Vg + off); } }
    if (tid < 192) st.bt = ((const float*)(A.ws + WS_BIAS))[(p * 8 + h) * 192 + tid];
}
__device__ __forceinline__ void attn_issue_q(const Args& A, int au, int tid, AttnStage& st) {
    int p, b, h, dil, res0, i0; attn_decode(au, p, b, h, dil, res0, i0);
    asm volatile("" : "+v"(tid));
    const bf16* Qg = (const bf16*)(A.ws + WS_Q); const size_t tokbase = (size_t)b * SEQ; const int c = tid & 7;
#pragma unroll
    for (int it = 0; it < 4; ++it) { const int R = (tid >> 3) + 64 * it; const int tok = p < 2 ? res0 + dil * (i0 + R) : res0 + (R >> 7) + 16 * (R & 127);
        st.qr[it] = *(const GAS v4u*)(Qg + (tokbase + tok) * 512 + h * 64 + c * 8); }
}
template <bool QPRE = false> __device__ __forceinline__ void attn_commit(const Args& A, LAS unsigned char* lds, int au, int tid, const AttnStage& st) {
    int p, b, h, dil, res0, i0; attn_decode(au, p, b, h, dil, res0, i0);
    asm volatile("" : "+v"(tid));
    const int c = tid & 7;
#pragma unroll
    for (int it = 0; it < 6; ++it) { const int R = (tid >> 3) + 64 * it; const bool ok = p < 2 ? (i0 - 128 + R >= 0) : (R < 256);
        if (ok) { *(LAS v4u*)(lds + AT_K + R * 128 + 16 * (c ^ ((R >> 1) & 7))) = st.kr[it];
                  *(LAS v4u*)(lds + AT_V + (c >> 2) * 24576 + (R >> 4) * 1024 + (R & 15) * 64 + (c & 3) * 16) = st.vr[it]; } }
    if constexpr (QPRE) {
#pragma unroll
      for (int it = 0; it < 4; ++it) { const int R = (tid >> 3) + 64 * it; *(LAS v4u*)(lds + AT_Q + R * 128 + 16 * (c ^ ((R >> 1) & 7))) = st.qr[it]; }
    } else { const bf16* Qg = (const bf16*)(A.ws + WS_Q); const size_t tokbase = (size_t)b * SEQ; v4u qr[4];
#pragma unroll
      for (int it = 0; it < 4; ++it) { const int R = (tid >> 3) + 64 * it; const int tok = p < 2 ? res0 + dil * (i0 + R) : res0 + (R >> 7) + 16 * (R & 127);
        qr[it] = *(const GAS v4u*)(Qg + (tokbase + tok) * 512 + h * 64 + c * 8); }
#pragma unroll
      for (int it = 0; it < 4; ++it) { const int R = (tid >> 3) + 64 * it; *(LAS v4u*)(lds + AT_Q + R * 128 + 16 * (c ^ ((R >> 1) & 7))) = qr[it]; } }
    if (tid < 192) ((LAS float*)(lds + AT_BT))[tid] = st.bt;
}
template <int VAR = 0, bool QPRE = false> __device__ __forceinline__ void attn_compute(const Args& A, LAS unsigned char* lds, int au, int tid, int lane, int w, int au_next = -1, AttnStage* stq = nullptr) {
    unsigned char* ws = A.ws;
    bf16* OP = (bf16*)(ws + WS_OP); float* LSE = (float*)(ws + WS_LSE);
    const int a = lane & 31, hh = lane >> 5;
    int p, b, h, dil, res0, i0; attn_decode(au, p, b, h, dil, res0, i0);
    const size_t tokbase = (size_t)b * SEQ;
    int q0, resw, rowoff;
    if (p < 2) { q0 = i0 + 32 * w; resw = res0; rowoff = 0; } else { q0 = 32 * (w & 3); resw = res0 + (w >> 2); rowoff = -128; }
    const int jmin = (4 - (q0 >> 5)) > 0 ? (4 - (q0 >> 5)) : 0;
    const size_t mq = tokbase + resw + (size_t)dil * (q0 + a);
    bf16x8 qf[4];
    { const int Rq = 32 * w + a; const LAS unsigned char* qp = lds + AT_Q + Rq * 128; const int sq = (Rq >> 1) & 7;
#pragma unroll
      for (int s = 0; s < 4; ++s) qf[s] = *(const LAS bf16x8*)(qp + 16 * ((2 * s + hh) ^ sq)); }
    const LAS float* rt = (const LAS float*)(lds + AT_BT) + (31 - a + 4 * hh);
    f32x16 S[5];
#pragma unroll
    for (int j = 0; j < 5; ++j) {
        if (j >= jmin) {
            const int Rk = 32 * (w + j) + rowoff + a;
#pragma unroll
            for (int r = 0; r < 16; ++r) S[j][r] = (VAR & 4) ? (float)(r + j) : rt[32 * j + (r & 3) + 8 * (r >> 2)];
            const LAS unsigned char* kp = lds + AT_K + Rk * 128; const int sw = (Rk >> 1) & 7;
            if (!(VAR & 2))
#pragma unroll
            for (int s = 0; s < 4; ++s) { const bf16x8 kf = *(const LAS bf16x8*)(kp + 16 * ((2 * s + hh) ^ sw)); S[j] = __builtin_amdgcn_mfma_f32_32x32x16_bf16(kf, qf[s], S[j], 0, 0, 0); }
            if (j == 0) {
#pragma unroll
                for (int r = 0; r < 16; ++r) if (crow(r, hh) < a) S[j][r] = NEGBIG;
            }
            if (j == 4) {
#pragma unroll
                for (int r = 0; r < 16; ++r) if (crow(r, hh) > a) S[j][r] = NEGBIG;
            }
        } else {
#pragma unroll
            for (int r = 0; r < 16; ++r) S[j][r] = NEGBIG;
        }
    }
    float mx = NEGBIG;
#pragma unroll
    for (int j = 0; j < 5; ++j)
        if (j >= jmin) {
#pragma unroll
            for (int r = 0; r < 16; ++r) mx = fmaxf(mx, S[j][r]);
        }
    mx = fmaxf(mx, swap32_other(mx));
    float l = 0.f;
#pragma unroll
    for (int j = 0; j < 5; ++j)
        if (j >= jmin) {
#pragma unroll
            for (int r = 0; r < 16; ++r) { const float e = __builtin_amdgcn_exp2f(S[j][r] - mx); S[j][r] = e; l += e; }
        }
    l += swap32_other(l);
    if constexpr (QPRE) { if (au_next >= 0) attn_issue_q(A, au_next, tid, *stq); }
    f32x16 o[2];
#pragma unroll
    for (int r = 0; r < 16; ++r) { o[0][r] = 0.f; o[1][r] = 0.f; }
    const LAS unsigned char* vb = lds + AT_V + ((lane >> 4) & 1) * 32 + (lane & 3) * 8 + (4 * hh + ((lane & 15) >> 2)) * 64;
#pragma unroll
    for (int j = 0; j < 5; ++j) {
        if (j >= jmin && !(VAR & 8)) {
            const int G0 = (32 * (w + j) + rowoff) >> 4;
#pragma unroll
            for (int s2 = 0; s2 < 2; ++s2) {
                v4u pw; pw.x = cvtpk(S[j][8 * s2 + 0], S[j][8 * s2 + 1]); pw.y = cvtpk(S[j][8 * s2 + 2], S[j][8 * s2 + 3]); pw.z = cvtpk(S[j][8 * s2 + 4], S[j][8 * s2 + 5]); pw.w = cvtpk(S[j][8 * s2 + 6], S[j][8 * s2 + 7]);
                const bf16x8 pf = __builtin_bit_cast(bf16x8, pw);
#pragma unroll
                for (int d0 = 0; d0 < 2; ++d0) {
                    const LAS unsigned char* vp = vb + d0 * 24576 + (G0 + s2) * 1024;
                    const s16x4 lo = vtr(vp), hi = vtr(vp + 512);
                    const bf16x8 vf = (bf16x8){lo[0], lo[1], lo[2], lo[3], hi[0], hi[1], hi[2], hi[3]};
                    o[d0] = __builtin_amdgcn_mfma_f32_32x32x16_bf16(vf, pf, o[d0], 0, 0, 0);
                }
            }
        }
    }
    const float inv = __builtin_amdgcn_rcpf(l);
    if (!(VAR & 16))
    { const int Rq = 32 * w + a; LAS unsigned char* op_ = lds + AT_Q + Rq * 128 + 8 * hh; const int sq = (Rq >> 1) & 7;
#pragma unroll
      for (int d0 = 0; d0 < 2; ++d0)
#pragma unroll
        for (int g4 = 0; g4 < 4; ++g4) { v2u ov; ov.x = cvtpk(o[d0][4 * g4 + 0] * inv, o[d0][4 * g4 + 1] * inv); ov.y = cvtpk(o[d0][4 * g4 + 2] * inv, o[d0][4 * g4 + 3] * inv);
            *(LAS v2u*)(op_ + 16 * ((4 * d0 + g4) ^ sq)) = ov; }
      asm volatile("s_waitcnt lgkmcnt(0)" ::: "memory");
#pragma unroll
      for (int it = 0; it < 4; ++it) { const int rr = (lane >> 3) + 8 * it, ch = lane & 7, Rr = 32 * w + rr;
        const v4u v = *(const LAS v4u*)(lds + AT_Q + Rr * 128 + 16 * (ch ^ ((Rr >> 1) & 7)));
        const size_t mrow = tokbase + resw + (size_t)dil * (q0 + rr);
        *(GAS v4u*)(OP + ((size_t)p * T + mrow) * 512 + h * 64 + ch * 8) = v; } }
    if (hh == 0 && (!(VAR & 16) || l == 12345.f)) LSE[((size_t)p * T + mq) * 8 + h] = mx + __builtin_amdgcn_logf(l) + ((VAR & 8) ? o[0][0] + o[1][5] : 0.f);
}

constexpr int SG_IMG = 0, SG_RSTD = 32768;
__device__ __forceinline__ void sgu_unit(const Args& A, LAS unsigned char* lds, int su, int tid, int lane, int w) {
    unsigned char* ws = A.ws;
    bf16* UA = (bf16*)(ws + WS_UA); const bf16* VA = (const bf16*)(ws + WS_VA);
    const float* nw = A.in[5]; const float* sw = A.in[6]; const float* sb = A.in[7];
    const int a = lane & 31, hh = lane >> 5;
    const int b = su >> 6, n = (su >> 2) & 15, g = su & 3; const size_t m0 = (size_t)b * SEQ + n * 128;
    v2u uu_[2][4];
    { const int tt_ = w >> 1, t_ = 32 * tt_ + a; const bf16* urow_ = UA + (m0 + t_) * 512 + g * 128;
#pragma unroll
      for (int cbi = 0; cbi < 2; ++cbi)
#pragma unroll
        for (int g4 = 0; g4 < 4; ++g4) uu_[cbi][g4] = *(const GAS v2u*)(urow_ + 32 * (2 * (w & 1) + cbi) + 8 * g4 + 4 * hh); }
    f32x4 wpre[8][2];
    { const int tt_ = w >> 1; const float* wrow_ = sw + ((size_t)(g * 128 + 32 * tt_ + a)) * 128;
#pragma unroll
      for (int st = 0; st < 8; ++st) if (st < 2 * tt_ + 2) { wpre[st][0] = *(const f32x4*)(wrow_ + 16 * st + 4 * hh); wpre[st][1] = *(const f32x4*)(wrow_ + 16 * st + 4 * hh + 8); } }
    { const int ch = tid & 15;
#pragma unroll
      for (int it = 0; it < 4; ++it) { const int s = (tid >> 4) + 32 * it;
        const v4u v = *(const GAS v4u*)(VA + (m0 + s) * 512 + g * 128 + ch * 8);
        float ss = 0.f;
#pragma unroll
        for (int i = 0; i < 4; ++i) { const float x0 = bf_lo(v[i]), x1 = bf_hi(v[i]); ss += x0 * x0 + x1 * x1; }
        ss = row16_sum(ss);
        *(LAS v4u*)(lds + SG_IMG + (ch >> 2) * 8192 + (s >> 4) * 1024 + (s & 15) * 64 + (ch & 3) * 16) = v;
        if (ch == 0) ((LAS float*)(lds + SG_RSTD))[s] = rsqrtf(ss * (1.0f / 128.0f) + EPS); } }
    __syncthreads();
    const int tt = w >> 1, t = 32 * tt + a;
    f32x16 acc[2];
#pragma unroll
    for (int r = 0; r < 16; ++r) { acc[0][r] = 0.f; acc[1][r] = 0.f; }
    const LAS unsigned char* vb = lds + SG_IMG + ((lane >> 4) & 1) * 32 + (lane & 3) * 8 + (4 * hh + ((lane & 15) >> 2)) * 64;
#pragma unroll
    for (int st = 0; st < 8; ++st) {
        if (st < 2 * tt + 2) {
            const int s0 = 16 * st + 4 * hh;
            const f32x4 w0 = wpre[st][0], w1 = wpre[st][1];
            const f32x4 r0 = *(const LAS f32x4*)(lds + SG_RSTD + 4 * s0), r1 = *(const LAS f32x4*)(lds + SG_RSTD + 4 * (s0 + 8));
            float e[8];
#pragma unroll
            for (int i = 0; i < 4; ++i) { e[i] = (s0 + i <= t) ? w0[i] * r0[i] : 0.f; e[4 + i] = (s0 + 8 + i <= t) ? w1[i] * r1[i] : 0.f; }
            v4u bw; bw.x = cvtpk(e[0], e[1]); bw.y = cvtpk(e[2], e[3]); bw.z = cvtpk(e[4], e[5]); bw.w = cvtpk(e[6], e[7]);
            const bf16x8 bfr = __builtin_bit_cast(bf16x8, bw);
#pragma unroll
            for (int cbi = 0; cbi < 2; ++cbi) { const int cb = 2 * (w & 1) + cbi;
                const LAS unsigned char* vp = vb + cb * 8192 + st * 1024;
                const s16x4 lo = vtr(vp), hi = vtr(vp + 512);
                const bf16x8 vf = (bf16x8){lo[0], lo[1], lo[2], lo[3], hi[0], hi[1], hi[2], hi[3]};
                acc[cbi] = __builtin_amdgcn_mfma_f32_32x32x16_bf16(vf, bfr, acc[cbi], 0, 0, 0); }
        }
    }
    const float bias = sb[g * 128 + t];
    bf16* urow = UA + (m0 + t) * 512 + g * 128;
#pragma unroll
    for (int cbi = 0; cbi < 2; ++cbi)
#pragma unroll
        for (int g4 = 0; g4 < 4; ++g4) { const int c0 = 32 * (2 * (w & 1) + cbi) + 8 * g4 + 4 * hh;
            const v2u uu = uu_[cbi][g4]; const f32x4 nv = *(const f32x4*)(nw + g * 128 + c0);
            const float y0 = bf_lo(uu.x) * (nv[0] * acc[cbi][4 * g4 + 0] + bias), y1 = bf_hi(uu.x) * (nv[1] * acc[cbi][4 * g4 + 1] + bias);
            const float y2 = bf_lo(uu.y) * (nv[2] * acc[cbi][4 * g4 + 2] + bias), y3 = bf_hi(uu.y) * (nv[3] * acc[cbi][4 * g4 + 3] + bias);
            v2u ov; ov.x = cvtpk(y0, y1); ov.y = cvtpk(y2, y3); *(GAS v2u*)(urow + c0) = ov; }
    __syncthreads();
}

__device__ __forceinline__ void p3_merge(const Args& A, int m_lo, int m_hi, int m_step, int lane) {
    unsigned char* ws = A.ws;
    const bf16* OP = (const bf16*)(ws + WS_OP); const float* LSE = (const float*)(ws + WS_LSE); const bf16* SG = (const bf16*)(ws + WS_UA); bf16* MIX = (bf16*)(ws + WS_H);
    const float* mw = A.in[8];
    const f32x4 wa0 = *(const f32x4*)(mw + 8 * lane), wa1 = *(const f32x4*)(mw + 8 * lane + 4), ws0 = *(const f32x4*)(mw + 512 + 8 * lane), ws1 = *(const f32x4*)(mw + 512 + 8 * lane + 4);
    for (int m = m_lo; m < m_hi; m += m_step) {
        const int h = lane >> 3;
        const float l0 = LSE[((size_t)0 * T + m) * 8 + h], l1 = LSE[((size_t)1 * T + m) * 8 + h], l2 = LSE[((size_t)2 * T + m) * 8 + h];
        const v4u o0 = *(const GAS v4u*)(OP + ((size_t)0 * T + m) * 512 + 8 * lane), o1 = *(const GAS v4u*)(OP + ((size_t)1 * T + m) * 512 + 8 * lane), o2 = *(const GAS v4u*)(OP + ((size_t)2 * T + m) * 512 + 8 * lane);
        const v4u sg = *(const GAS v4u*)(SG + (size_t)m * 512 + 8 * lane);
        const float mxl = fmaxf(l0, fmaxf(l1, l2));
        float e0 = __builtin_amdgcn_exp2f(l0 - mxl), e1 = __builtin_amdgcn_exp2f(l1 - mxl), e2 = __builtin_amdgcn_exp2f(l2 - mxl);
        const float inv = __builtin_amdgcn_rcpf(e0 + e1 + e2); e0 *= inv; e1 *= inv; e2 *= inv;
        float at[8], sv[8]; float ssa = 0.f, sss = 0.f;
#pragma unroll
        for (int i = 0; i < 4; ++i) {
            at[2 * i] = e0 * bf_lo(o0[i]) + e1 * bf_lo(o1[i]) + e2 * bf_lo(o2[i]); at[2 * i + 1] = e0 * bf_hi(o0[i]) + e1 * bf_hi(o1[i]) + e2 * bf_hi(o2[i]);
            sv[2 * i] = bf_lo(sg[i]); sv[2 * i + 1] = bf_hi(sg[i]);
            ssa += at[2 * i] * at[2 * i] + at[2 * i + 1] * at[2 * i + 1]; sss += sv[2 * i] * sv[2 * i] + sv[2 * i + 1] * sv[2 * i + 1];
        }
        const float ra = rsqrtf(wave_sum(ssa) * (1.0f / 512.0f) + EPS), rs = rsqrtf(wave_sum(sss) * (1.0f / 512.0f) + EPS);
        v4u oa, os;
        oa.x = cvtpk(at[0] * ra * wa0[0], at[1] * ra * wa0[1]); oa.y = cvtpk(at[2] * ra * wa0[2], at[3] * ra * wa0[3]); oa.z = cvtpk(at[4] * ra * wa1[0], at[5] * ra * wa1[1]); oa.w = cvtpk(at[6] * ra * wa1[2], at[7] * ra * wa1[3]);
        os.x = cvtpk(sv[0] * rs * ws0[0], sv[1] * rs * ws0[1]); os.y = cvtpk(sv[2] * rs * ws0[2], sv[3] * rs * ws0[3]); os.z = cvtpk(sv[4] * rs * ws1[0], sv[5] * rs * ws1[1]); os.w = cvtpk(sv[6] * rs * ws1[2], sv[7] * rs * ws1[3]);
        *(GAS v4u*)(MIX + (size_t)m * 1024 + 8 * lane) = oa; *(GAS v4u*)(MIX + (size_t)m * 1024 + 512 + 8 * lane) = os;
    }
}
#ifndef MK_SP2
#define MK_SP2 true
#endif
#ifndef MK_ALIGN1
#define MK_ALIGN1 true
#endif
#ifndef MK_ALIGN3
#define MK_ALIGN3 true
#endif
#ifndef MK_DUP
#define MK_DUP 0
#endif

__device__ __forceinline__ int f2key(unsigned bits) { return (int)bits; }
__device__ __forceinline__ int imax(int a, int b) { int d; asm("v_max_f32 %0, %1, %2" : "=v"(d) : "v"(a), "v"(b)); return d; }
__device__ __forceinline__ int imin(int a, int b) { int d; asm("v_min_f32 %0, %1, %2" : "=v"(d) : "v"(a), "v"(b)); return d; }
#define SN_CE(a_, b_) { const int x_ = v[OFF + (a_)], y_ = v[OFF + (b_)]; v[OFF + (a_)] = imax(x_, y_); v[OFF + (b_)] = imin(x_, y_); }
template <int OFF> __device__ __forceinline__ void sort16_desc(int (&v)[64]) {
    SN_CE(0,13) SN_CE(1,12) SN_CE(2,15) SN_CE(3,14) SN_CE(4,8) SN_CE(5,6) SN_CE(7,11) SN_CE(9,10)
    SN_CE(0,5) SN_CE(1,7) SN_CE(2,9) SN_CE(3,4) SN_CE(6,13) SN_CE(8,14) SN_CE(10,15) SN_CE(11,12)
    SN_CE(0,1) SN_CE(2,3) SN_CE(4,5) SN_CE(6,8) SN_CE(7,9) SN_CE(10,11) SN_CE(12,13) SN_CE(14,15)
    SN_CE(0,2) SN_CE(1,3) SN_CE(4,10) SN_CE(5,11) SN_CE(6,7) SN_CE(8,9) SN_CE(12,14) SN_CE(13,15)
    SN_CE(1,2) SN_CE(3,12) SN_CE(4,6) SN_CE(5,7) SN_CE(8,10) SN_CE(9,11) SN_CE(13,14)
    SN_CE(1,4) SN_CE(2,6) SN_CE(5,8) SN_CE(7,10) SN_CE(9,13) SN_CE(11,14)
    SN_CE(2,4) SN_CE(3,6) SN_CE(9,12) SN_CE(11,13)
    SN_CE(3,5) SN_CE(6,8) SN_CE(7,9) SN_CE(10,12)
    SN_CE(3,4) SN_CE(5,6) SN_CE(7,8) SN_CE(9,10) SN_CE(11,12)
    SN_CE(6,7) SN_CE(8,9)
}
#undef SN_CE
template <int OFF> __device__ __forceinline__ void bitonic_merge16_desc(int (&v)[64]) {
#pragma unroll
    for (int j = 8; j > 0; j >>= 1)
#pragma unroll
        for (int i = 0; i < 16; ++i) { const int l = i ^ j;
            if (l > i) { const int x = v[OFF + i], y = v[OFF + l]; v[OFF + i] = imax(x, y); v[OFF + l] = imin(x, y); } }
}
template <int A_, int B_> __device__ __forceinline__ void merge_top16(int (&v)[64]) {
#pragma unroll
    for (int i = 0; i < 16; ++i) v[A_ + i] = imax(v[A_ + i], v[B_ + 15 - i]);
    bitonic_merge16_desc<A_>(v);
}
__device__ __forceinline__ void top16_of_64(int (&v)[64]) {
    sort16_desc<0>(v); sort16_desc<16>(v); sort16_desc<32>(v); sort16_desc<48>(v);
    merge_top16<0, 16>(v); merge_top16<32, 48>(v); merge_top16<0, 32>(v);
}
__host__ __device__ constexpr int hyp_off(int i) { int o = 0; for (int k = 0; k < i; ++k) o += 16 / (k + 1); return o; }
static_assert(hyp_off(16) == 50, "50 candidates");
__device__ __forceinline__ int swap32_other_i(int x) {
    auto s = __builtin_amdgcn_permlane32_swap((unsigned)x, (unsigned)x, false, false);
    return (threadIdx.x & 32) ? (int)s[0] : (int)s[1];
}

__device__ __forceinline__ void route_tile(const Args& A, LAS unsigned char* stg, LAS unsigned char* kl8, LAS unsigned short* idxL, LAS float* gateL, size_t m0, int tl0, int h, int lane) {
    unsigned char* ws = A.ws;
    const unsigned short* SC = (const unsigned short*)(ws + WS_PQ);
    const int a = lane & 31, hh = lane >> 5;
    int top[2][16];
#pragma unroll
    for (int half = 0; half < 2; ++half) {
        v4u sr[8];
#pragma unroll
        for (int it = 0; it < 8; ++it) sr[it] = *(const GAS v4u*)(SC + (m0 + (lane >> 4) + 4 * it) * 2048 + h * 256 + half * 128 + (lane & 15) * 8);
#pragma unroll
        for (int it = 0; it < 8; ++it) { const int row = (lane >> 4) + 4 * it; *(LAS v4u*)(stg + row * 256 + 16 * ((lane & 15) ^ (row & 15))) = sr[it]; }
        asm volatile("s_waitcnt lgkmcnt(0)" ::: "memory");
        int v[64];
#pragma unroll
        for (int j = 0; j < 8; ++j) { const v4u d = *(const LAS v4u*)(stg + a * 256 + 16 * ((8 * hh + j) ^ (a & 15)));
#pragma unroll
            for (int i = 0; i < 4; ++i) { const unsigned key = 64 * hh + 8 * j + 2 * i;
                const float f0 = (float)__builtin_bit_cast(_Float16, (unsigned short)(d[i] & 0xffffu)), f1 = (float)__builtin_bit_cast(_Float16, (unsigned short)(d[i] >> 16));
                v[8 * j + 2 * i] = f2key((__float_as_uint(f0) & 0xffffff80u) | key); v[8 * j + 2 * i + 1] = f2key((__float_as_uint(f1) & 0xffffff80u) | (key + 1)); } }
        asm volatile("s_waitcnt lgkmcnt(0)" ::: "memory");
        top16_of_64(v);
#pragma unroll
        for (int i = 0; i < 16; ++i) v[16 + i] = swap32_other_i(v[i]);
        merge_top16<0, 16>(v);
#pragma unroll
        for (int i = 0; i < 16; ++i) top[half][i] = f2key((unsigned)v[i]);
    }
    LAS unsigned char* kl = kl8 + lane;
#pragma unroll
    for (int i = 0; i < 16; ++i) { kl[64 * i] = (unsigned char)((unsigned)top[0][i] & 0x7fu); kl[64 * (16 + i)] = (unsigned char)((unsigned)top[1][i] & 0x7fu); }
    int v[64];
    { constexpr unsigned NEGK = 0xff800000u;
#define CAND(i_, j_) f2key((__float_as_uint(__uint_as_float((unsigned)top[0][i_] & 0xffffff80u) + __uint_as_float((unsigned)top[1][j_] & 0xffffff80u)) & 0xffffff00u) | (unsigned)((i_) * 16 + (j_)))
      int ca[32], cb[32];
#pragma unroll
      for (int j = 0; j < 16; ++j) ca[j] = CAND(0, j);
#pragma unroll
      for (int j = 0; j < 8; ++j) { ca[16 + j] = CAND(1, j); ca[24 + j] = CAND(8 + j, 0); }
      { int k = 0;
#pragma unroll
        for (int i = 2; i < 8; ++i)
#pragma unroll
          for (int j = 0; j < 16; ++j) if ((i + 1) * (j + 1) <= 16) { cb[k] = CAND(i, j); ++k; }
#pragma unroll
        for (; k < 32; ++k) cb[k] = f2key(NEGK); }
#pragma unroll
      for (int k = 0; k < 32; ++k) v[k] = hh ? cb[k] : ca[k];
#undef CAND
    }
    sort16_desc<0>(v); sort16_desc<16>(v); merge_top16<0, 16>(v);
#pragma unroll
    for (int i = 0; i < 16; ++i) v[16 + i] = swap32_other_i(v[i]);
    merge_top16<0, 16>(v);
    float g[16]; float den = 0.f; const float b0 = __uint_as_float((unsigned)f2key((unsigned)v[0]) & 0xffffff00u);
#pragma unroll
    for (int r = 0; r < 16; ++r) { g[r] = __builtin_amdgcn_exp2f((__uint_as_float((unsigned)f2key((unsigned)v[r]) & 0xffffff00u) - b0) * LOG2E); den += g[r]; }
    const float inv = __builtin_amdgcn_rcpf(den);
#pragma unroll
    for (int r = 0; r < 16; ++r) {
        if ((r >> 3) == hh) {
            const unsigned ij = (unsigned)f2key((unsigned)v[r]) & 0xffu;
            const unsigned e = (unsigned)kl[64 * (ij >> 4)] * 128u + (unsigned)kl[64 * (16 + (ij & 15u))];
            idxL[((tl0 + a) * 16 + r) * 8 + h] = (unsigned short)e; gateL[((tl0 + a) * 16 + r) * 8 + h] = g[r] * inv;
#ifdef MK_WRITE_SEL
            { v2u o; o.x = e; o.y = __float_as_uint(g[r] * inv); *(GAS v2u*)((v2u*)(ws + WS_SEL) + (m0 + a) * 128 + h * 16 + r) = o; }
#endif
        }
    }
    asm volatile("s_waitcnt lgkmcnt(0)" ::: "memory");
}

constexpr size_t P7_SLICE_ELEMS = (size_t)16384 * 64;
__device__ __forceinline__ int sdot4_z(int a, int b) { int d; asm("v_dot4_i32_i8 %0, %1, %2, 0" : "=v"(d) : "v"(a), "v"(b)); return d; }
__device__ __forceinline__ void p7_pace(unsigned* ctl_words, int grp) {
    __syncthreads();
    if (threadIdx.x == 0) { unsigned* cnt = ctl_words + CW_GRP + 64 * grp; unsigned* gen = ctl_words + CW_GGEN + 64 * grp;
        const unsigned old = xb_add(cnt, 1u), g_ = old / 32u;
        if (old + 1u == (g_ + 1u) * 32u) xb_add(gen, 1u); else XB_SPIN(xb_ld(gen) == g_, ctl_words + CW_BAR); }
    __syncthreads();
}
template <int PMODE = 0> __device__ __forceinline__ void p7_sliced(const Args& A, LAS unsigned char* lds, int vcu, int lane, int w, float* out, const XcdBarrier& bar) {
    unsigned char* ws = A.ws;
    const bf16* U = (const bf16*)(ws + WS_U); const bf16* V = (const bf16*)(ws + WS_V); const bf16* X1B = (const bf16*)(ws + WS_X1B);
    const float* rowsq = (const float*)(ws + WS_ROWSQ);
    const int g = lane >> 2, c = lane & 3;
    const size_t mbase = (size_t)vcu * 64 + w * 8;
    { LAS unsigned char* stg_ = lds + 49152 + w * 8192; LAS unsigned char* kl8_ = lds + 114688 + w * 2048;
      route_tile(A, stg_, kl8_, (LAS unsigned short*)lds, (LAS float*)(lds + 16384), (size_t)vcu * 64 + 32 * (w & 1), 32 * (w & 1), w >> 1, lane);
      route_tile(A, stg_, kl8_, (LAS unsigned short*)lds, (LAS float*)(lds + 16384), (size_t)vcu * 64 + 32 * (w & 1), 32 * (w & 1), (w >> 1) + 4, lane); }
    __syncthreads();
    LAS unsigned short* idxL = (LAS unsigned short*)(lds + w * 2048);
#ifdef MK_TOUCH7
    unsigned tacc = 0u, tch = 0u; const int toff = (((vcu & 31) * NWAVES + w) << 13) + (lane << 7);
#define P7_TOUCH(TBL, jj) __builtin_amdgcn_raw_buffer_load_b32(__builtin_amdgcn_make_buffer_rsrc((void*)(ws + (TBL) + (size_t)(jj) * ((size_t)16384 * 128)), 0, 16384 * 128, 0x00020000), toff, 0, 0)
#endif
    LAS float* gateL = (LAS float*)(lds + 16384 + w * 4096);
    float rs[8];
#pragma unroll
    for (int tk = 0; tk < 8; ++tk) rs[tk] = rsqrtf(row16_sum(rowsq[(mbase + tk) * 16 + (lane & 15)]) * (1.0f / 1024.0f) + EPS);
    LAS signed char* x8 = (LAS signed char*)(lds + 49152 + w * 8192);
    float sxs[8];
#pragma unroll
    for (int tk = 0; tk < 8; ++tk) {
        const bf16* xr = X1B + (mbase + tk) * 1024 + 16 * lane;
        const v4u x0 = *(const GAS v4u*)xr, x1 = *(const GAS v4u*)(xr + 8);
        float f[16]; float am = 0.f;
#pragma unroll
        for (int i = 0; i < 4; ++i) { f[2 * i] = bf_lo(x0[i]); f[2 * i + 1] = bf_hi(x0[i]); f[8 + 2 * i] = bf_lo(x1[i]); f[8 + 2 * i + 1] = bf_hi(x1[i]); }
#pragma unroll
        for (int i = 0; i < 16; ++i) am = fmaxf(am, fabsf(f[i]));
        am = wave_max(am);
        const float inv = am > 0.f ? 127.0f / am : 0.f;
        v4u o;
#pragma unroll
        for (int i = 0; i < 4; ++i) o[i] = pack_i8x4((f32x4){f[4 * i], f[4 * i + 1], f[4 * i + 2], f[4 * i + 3]}, inv);
        *(LAS v4u*)(x8 + tk * 1024 + 16 * lane) = o;
        sxs[tk] = am * (1.0f / 127.0f) * rs[tk];
    }
    int acc[8][8];
#pragma unroll
    for (int tk = 0; tk < 8; ++tk)
#pragma unroll
        for (int q = 0; q < 8; ++q) acc[tk][q] = 0;
    const unsigned c16 = 16u * (unsigned)c;
#define P7A_ISSUE(BUF, jj, s_) do { \
        const __amdgpu_buffer_rsrc_t rs_ = __builtin_amdgcn_make_buffer_rsrc((void*)(ws + WS_U + (size_t)(jj) * ((size_t)16384 * 128)), 0, 16384 * 128, 0x00020000);        \
        const unsigned idw_ = *(const LAS unsigned*)(idxL + (((s_) >> 2) * 16 + g) * 8 + 2 * ((s_) & 3)); \
        const int o0_ = (int)(((idw_ & 0xffffu) << 7) | c16), o1_ = (int)(((idw_ >> 16) << 7) | c16); \
        BUF[0] = __builtin_bit_cast(v4u, __builtin_amdgcn_raw_buffer_load_b128(rs_, o0_, 0, 0)); BUF[1] = __builtin_bit_cast(v4u, __builtin_amdgcn_raw_buffer_load_b128(rs_, o0_ + 64, 0, 0)); \
        BUF[2] = __builtin_bit_cast(v4u, __builtin_amdgcn_raw_buffer_load_b128(rs_, o1_, 0, 0)); BUF[3] = __builtin_bit_cast(v4u, __builtin_amdgcn_raw_buffer_load_b128(rs_, o1_ + 64, 0, 0)); } while (0)
#define P7A_MATH(BUF, XA, XB, s_) do { \
        _Pragma("unroll") for (int qq_ = 0; qq_ < 2; ++qq_) { int d_ = acc[(s_) >> 2][2 * ((s_) & 3) + qq_]; \
            _Pragma("unroll") for (int i_ = 0; i_ < 4; ++i_) { d_ = __builtin_amdgcn_sdot4((int)BUF[2 * qq_][i_], (int)XA[i_], d_, false); d_ = __builtin_amdgcn_sdot4((int)BUF[2 * qq_ + 1][i_], (int)XB[i_], d_, false); } \
            acc[(s_) >> 2][2 * ((s_) & 3) + qq_] = d_; } } while (0)
    {
        v4u b0[4], b1[4], b2[4], b3[4];
        if (!(PMODE & 2)) { P7A_ISSUE(b0, 0, 0); P7A_ISSUE(b1, 0, 1); P7A_ISSUE(b2, 0, 2); }
        for (int j = 0; j < ((PMODE & 2) ? 0 : 8); ++j) {
            const int jn = j < 7 ? j + 1 : 7;
#if defined(MK_P7_LSYNC) && (MK_P7_LSYNC & 64)
            if (PMODE == 0 && j == 4) xcd_barrier(bar); else
#endif
#if defined(MK_P7_LSYNC) && (MK_P7_LSYNC & 1)
            if (PMODE == 0 && j) p7_pace((unsigned*)(ws + WS_CTL), (int)(blockIdx.x & 7));
#endif
#if defined(MK_P7_LSYNC) && (MK_P7_LSYNC & 32)
            if (PMODE == 0 && j == 0) p7_pace((unsigned*)(ws + WS_CTL), (int)(blockIdx.x & 7));
#endif
#if defined(MK_P7_LSYNC) && (MK_P7_LSYNC & 16)
            if (PMODE == 0 && j && (j & 1) == 0) p7_pace((unsigned*)(ws + WS_CTL), (int)(blockIdx.x & 7));
#endif
#pragma unroll
            for (int tk = 0; tk < 8; ++tk) {
#if defined(MK_P7_LSYNC) && (MK_P7_LSYNC & 512)
                if (PMODE == 0 && tk == 4) __syncthreads();
#endif
                const v4u xa = *(const LAS v4u*)(x8 + tk * 1024 + 128 * j + 16 * c), xb = *(const LAS v4u*)(x8 + tk * 1024 + 128 * j + 64 + 16 * c);
#ifdef MK_TOUCH7
                if (tk == 0) tacc ^= tch;
                if (tk == 7) tch = (j < 7) ? (unsigned)P7_TOUCH(WS_U, j + 1) : (unsigned)P7_TOUCH(WS_V, 0);
#endif
                P7A_ISSUE(b3, j, 4 * tk + 3); __builtin_amdgcn_sched_barrier(0);
                P7A_MATH(b0, xa, xb, 4 * tk + 0); __builtin_amdgcn_sched_barrier(0);
                if (tk < 7) P7A_ISSUE(b0, j, 4 * tk + 4); else P7A_ISSUE(b0, jn, 0);
                __builtin_amdgcn_sched_barrier(0);
                P7A_MATH(b1, xa, xb, 4 * tk + 1); __builtin_amdgcn_sched_barrier(0);
                if (tk < 7) P7A_ISSUE(b1, j, 4 * tk + 5); else P7A_ISSUE(b1, jn, 1);
                __builtin_amdgcn_sched_barrier(0);
                P7A_MATH(b2, xa, xb, 4 * tk + 2); __builtin_amdgcn_sched_barrier(0);
                if (tk < 7) P7A_ISSUE(b2, j, 4 * tk + 6); else P7A_ISSUE(b2, jn, 2);
                __builtin_amdgcn_sched_barrier(0);
                P7A_MATH(b3, xa, xb, 4 * tk + 3); __builtin_amdgcn_sched_barrier(0);
            }
        }
    }
#undef P7A_ISSUE
#undef P7A_MATH
    const float* SU = (const float*)(ws + WS_SU); const float* SV = (const float*)(ws + WS_SV);
    unsigned w4[8][2]; float sw[8];
#pragma unroll
    for (int tk = 0; tk < 8; ++tk) {
        const LAS f32x4* gp = (const LAS f32x4*)(gateL + (tk * 16 + g) * 8); const f32x4 g0 = gp[0], g1 = gp[1];
        const v4u id = *(const LAS v4u*)(idxL + (tk * 16 + g) * 8);
        float wq[8];
#pragma unroll
        for (int q = 0; q < 8; ++q) { int s = acc[tk][q]; s += __builtin_amdgcn_mov_dpp(s, 0xB1, 0xf, 0xf, true); s += __builtin_amdgcn_mov_dpp(s, 0x4E, 0xf, 0xf, true);
            const unsigned e = (id[q >> 1] >> (16 * (q & 1))) & 0xffffu;
            wq[q] = (q < 4 ? g0[q & 3] : g1[q & 3]) * gelu_tanh_f(sxs[tk] * SU[e] * (float)s) * SV[e]; }
        float am = 0.f;
#pragma unroll
        for (int q = 0; q < 8; ++q) am = fmaxf(am, fabsf(wq[q]));
        am = wave_max(am);
        const float inv = am > 0.f ? 127.0f / am : 0.f; sw[tk] = am * (1.0f / 127.0f);
#pragma unroll
        for (int k = 0; k < 2; ++k) w4[tk][k] = pack_i8x4((f32x4){wq[4 * k], wq[4 * k + 1], wq[4 * k + 2], wq[4 * k + 3]}, inv);
    }
#define P7B_ISSUE(BUF, jj, s_) do { \
        const __amdgpu_buffer_rsrc_t rs_ = __builtin_amdgcn_make_buffer_rsrc((void*)(ws + WS_V + (size_t)(jj) * ((size_t)16384 * 128)), 0, 16384 * 128, 0x00020000); \
        const v2u id_ = *(const LAS v2u*)(idxL + (((s_) >> 1) * 16 + g) * 8 + 4 * ((s_) & 1)); \
        _Pragma("unroll") for (int qq_ = 0; qq_ < 4; ++qq_) { const unsigned e_ = (id_[qq_ >> 1] >> (16 * (qq_ & 1))) & 0xffffu; const int o_ = (int)((e_ << 7) | c16); \
            BUF[2 * qq_] = __builtin_bit_cast(v4u, __builtin_amdgcn_raw_buffer_load_b128(rs_, o_, 0, 0)); BUF[2 * qq_ + 1] = __builtin_bit_cast(v4u, __builtin_amdgcn_raw_buffer_load_b128(rs_, o_ + 64, 0, 0)); } } while (0)
#define P7B_MATH(BUF, s_) do { const int wq_ = (int)w4[(s_) >> 1][(s_) & 1]; if (PMODE & 8) { y[(s_) & 31] += (int)(BUF[0][0] ^ BUF[1][1] ^ BUF[2][2] ^ BUF[3][3] ^ BUF[4][0] ^ BUF[5][1] ^ BUF[6][2] ^ BUF[7][3]) & wq_; } else \
        _Pragma("unroll") for (int ch_ = 0; ch_ < 2; ++ch_) \
        _Pragma("unroll") for (int i_ = 0; i_ < 4; ++i_) { const unsigned a_ = BUF[0 + ch_][i_], b_ = BUF[2 + ch_][i_], c_ = BUF[4 + ch_][i_], d_ = BUF[6 + ch_][i_]; \
            const unsigned pl_ = __builtin_amdgcn_perm(b_, a_, 0x05010400u), ph_ = __builtin_amdgcn_perm(b_, a_, 0x07030602u), ql_ = __builtin_amdgcn_perm(d_, c_, 0x05010400u), qh_ = __builtin_amdgcn_perm(d_, c_, 0x07030602u); \
            y[16 * ch_ + 4 * i_ + 0] = ((s_) & 1) ? __builtin_amdgcn_sdot4((int)__builtin_amdgcn_perm(ql_, pl_, 0x05040100u), wq_, y[16 * ch_ + 4 * i_ + 0], false) : sdot4_z((int)__builtin_amdgcn_perm(ql_, pl_, 0x05040100u), wq_); \
            y[16 * ch_ + 4 * i_ + 1] = ((s_) & 1) ? __builtin_amdgcn_sdot4((int)__builtin_amdgcn_perm(ql_, pl_, 0x07060302u), wq_, y[16 * ch_ + 4 * i_ + 1], false) : sdot4_z((int)__builtin_amdgcn_perm(ql_, pl_, 0x07060302u), wq_); \
            y[16 * ch_ + 4 * i_ + 2] = ((s_) & 1) ? __builtin_amdgcn_sdot4((int)__builtin_amdgcn_perm(qh_, ph_, 0x05040100u), wq_, y[16 * ch_ + 4 * i_ + 2], false) : sdot4_z((int)__builtin_amdgcn_perm(qh_, ph_, 0x05040100u), wq_); \
            y[16 * ch_ + 4 * i_ + 3] = ((s_) & 1) ? __builtin_amdgcn_sdot4((int)__builtin_amdgcn_perm(qh_, ph_, 0x07060302u), wq_, y[16 * ch_ + 4 * i_ + 3], false) : sdot4_z((int)__builtin_amdgcn_perm(qh_, ph_, 0x07060302u), wq_); } } while (0)
    {
        v4u b0[8], b1[8], b2[8], b3[8];
#ifdef MK_X1_BF16
        const size_t eo_lane = (size_t)((g >> 3) * 64 + 16 * c + 2 * (g & 7));
        unsigned hi_nxt = 0u; if (!(PMODE & 1)) hi_nxt = __builtin_nontemporal_load((const GAS unsigned*)(X1B + mbase * 1024 + eo_lane));
#endif
        if (!(PMODE & 1)) { P7B_ISSUE(b0, 0, 0); P7B_ISSUE(b1, 0, 1); P7B_ISSUE(b2, 0, 2); }
        for (int j = 0; j < ((PMODE & 1) ? 0 : 8); ++j) {
            const int jn = j < 7 ? j + 1 : 7;
#if defined(MK_P7_LSYNC) && (MK_P7_LSYNC & 128)
            if (PMODE == 0 && j) __syncthreads();
#endif
#if defined(MK_P7_LSYNC) && (MK_P7_LSYNC & 2)
            if (PMODE == 0 && j) p7_pace((unsigned*)(ws + WS_CTL), (int)(blockIdx.x & 7));
#endif
#if defined(MK_P7_LSYNC) && (MK_P7_LSYNC & 4)
            if (PMODE == 0 && j == 0) p7_pace((unsigned*)(ws + WS_CTL), (int)(blockIdx.x & 7));
#endif
#pragma unroll
            for (int tp = 0; tp < 4; ++tp) {
#if defined(MK_P7_LSYNC) && (MK_P7_LSYNC & 256)
                if (PMODE == 0 && tp == 2) __syncthreads();
#endif
#pragma unroll
                for (int half = 0; half < 2; ++half) {
                    const int tk = 2 * tp + half;
                    int y[32];
#pragma unroll
                    for (int i = 0; i < 32; ++i) y[i] = 0;
                    float* op = out + (mbase + tk) * 1024 + 128 * j + (g >> 3) * 64 + 16 * c + 2 * (g & 7);
#ifdef MK_HILO
                    unsigned hi_raw = 0u; (void)hi_raw;
                    f32x2_t ov = {0.f, 0.f}; if (!(PMODE & 16)) { const size_t eo_ = (mbase + tk) * 1024 + 128 * j + (g >> 3) * 64 + 16 * c + 2 * (g & 7);
#ifdef MK_X1_BF16
                        (void)eo_; hi_raw = hi_nxt; const size_t en_ = tk < 7 ? (mbase + tk + 1) * 1024 + 128 * j + eo_lane : mbase * 1024 + 128 * jn + eo_lane;
                        hi_nxt = __builtin_nontemporal_load((const GAS unsigned*)(X1B + en_)); }
#else
                        const unsigned hi_ = *(const GAS unsigned*)(X1B + eo_), lo_ = *(const GAS unsigned*)(x1lo_ptr(ws, mbase + tk) + (eo_ & 1023));
                        ov = (f32x2_t){bf_lo(hi_) + bf_lo(lo_), bf_hi(hi_) + bf_hi(lo_)}; }
#endif
#else
                    f32x2_t ov = {0.f, 0.f}; if (!(PMODE & 16)) ov = *(const GAS f32x2_t*)op;
#endif
                    if (half == 0) {
                        P7B_ISSUE(b3, j, 4 * tp + 3); __builtin_amdgcn_sched_barrier(0);
                        P7B_MATH(b0, 4 * tp + 0); __builtin_amdgcn_sched_barrier(0);
                        if (tp < 3) P7B_ISSUE(b0, j, 4 * tp + 4); else P7B_ISSUE(b0, jn, 0);
                        __builtin_amdgcn_sched_barrier(0);
                        P7B_MATH(b1, 4 * tp + 1); __builtin_amdgcn_sched_barrier(0);
                    } else {
                        if (tp < 3) P7B_ISSUE(b1, j, 4 * tp + 5); else P7B_ISSUE(b1, jn, 1);
                        __builtin_amdgcn_sched_barrier(0);
                        P7B_MATH(b2, 4 * tp + 2); __builtin_amdgcn_sched_barrier(0);
                        if (tp < 3) P7B_ISSUE(b2, j, 4 * tp + 6); else P7B_ISSUE(b2, jn, 2);
                        __builtin_amdgcn_sched_barrier(0);
                        P7B_MATH(b3, 4 * tp + 3); __builtin_amdgcn_sched_barrier(0);
                    }
                    int z[16];
#pragma unroll
                    for (int k = 0; k < 16; ++k) { if (PMODE & 4) { z[k] = y[k] + y[16 + k]; } else { auto r = __builtin_amdgcn_permlane32_swap((unsigned)y[k], (unsigned)y[16 + k], false, false); z[k] = (int)r[0] + (int)r[1]; } }
                    int z2[8];
#pragma unroll
                    for (int k = 0; k < 8; ++k) { if (PMODE & 4) { z2[k] = z[k] + z[8 + k]; } else { auto r = __builtin_amdgcn_permlane16_swap((unsigned)z[k], (unsigned)z[8 + k], false, false); z2[k] = (int)r[0] + (int)r[1]; } }
                    int z3[4];
#pragma unroll
                    for (int k = 0; k < 4; ++k) { const int keep = (lane & 8) ? z2[4 + k] : z2[k], send = (lane & 8) ? z2[k] : z2[4 + k]; z3[k] = keep + __builtin_amdgcn_mov_dpp(send, 0x128, 0xf, 0xf, true); }
                    int z4[2];
#pragma unroll
                    for (int k = 0; k < 2; ++k) { const int keep = (lane & 4) ? z3[2 + k] : z3[k], send = (lane & 4) ? z3[k] : z3[2 + k];
                        z4[k] = keep + __builtin_amdgcn_mov_dpp(__builtin_amdgcn_mov_dpp(send, 0x1B, 0xf, 0xf, true), 0x141, 0xf, 0xf, true); }
#ifdef MK_X1_BF16
                    ov = (f32x2_t){bf_lo(hi_raw), bf_hi(hi_raw)};
#endif
                    f32x2_t res; res.x = ov.x + sw[tk] * (float)z4[0]; res.y = ov.y + sw[tk] * (float)z4[1];
                    if (!(PMODE & 16) || res.x == 12345.678f) __builtin_nontemporal_store(res, (GAS f32x2_t*)op);
                    __builtin_amdgcn_sched_barrier(0);
                }
            }
        }
    }
#ifdef MK_TOUCH7
    tacc ^= tch; if (tacc == 0x9e3779b9u) ((unsigned*)(ws + WS_CTL))[65536 + lane] = tacc;
#undef P7_TOUCH
#endif
#undef P7B_ISSUE
#undef P7B_MATH
}

__global__ void __launch_bounds__(NWAVES * 64, 2) mega_fwd(Args args) {
    extern __shared__ __attribute__((aligned(16))) unsigned char lds_raw[];
    LAS unsigned char* lds = (LAS unsigned char*)lds_raw;
    volatile LAS unsigned* MISC = (volatile LAS unsigned*)(lds + MISC_OFF);
    const int tid = threadIdx.x, lane = tid & 63, wave = __builtin_amdgcn_readfirstlane(tid >> 6);
    const int G = gridDim.x; const int bx = blockIdx.x; const int vcu = (G % 8 == 0) ? (bx % 8) * (G / 8) + bx / 8 : bx;
    const int gw = vcu * NWAVES + wave, NGW = G * NWAVES;
    unsigned char* ws = args.ws;
    gu32* ctl = (gu32*)(ws + WS_CTL);
    for (int u = tid; u < (LDS_BYTES - LDSCTL_OFF) / 4; u += NWAVES * 64) ((LAS unsigned*)(lds + LDSCTL_OFF))[u] = 0u;
    __syncthreads();
    XcdBarrier bar = xcd_barrier_post((unsigned*)(ctl + CW_BAR), MISC + 8);
    const int lo = args.ph_lo, hi = args.ph_hi;
#define IN(k) (lo <= (k) && (k) < hi)
#define BOTH(k) (IN(k) && IN((k) + 1))
#define GRID_BAR() xcd_barrier(bar)

#ifdef MK_STAMP
    unsigned long long ts_[9]; ts_[0] = __builtin_amdgcn_s_memrealtime();
#define STAMP(k) ts_[(k) + 1] = __builtin_amdgcn_s_memrealtime()
#else
#define STAMP(k) do {} while (0)
#endif
#ifndef MK_DUP
#define MK_DUP 0
#endif
#if (MK_DUP & 64)
    if (IN(0)) { for (int u = vcu; u < 256; u += G) p0_wf_unit(args, lds, u, tid, lane, wave); }
#endif
#if (MK_DUP & 256)
    if (IN(0)) { p0_prologue(args, lds, gw, NGW, wave, lane); }
#endif
#if (MK_DUP & 1)
    if (IN(0)) { p0_fused(args, lds, vcu, gw, NGW, tid, wave, lane); GRID_BAR(); }
#endif
    if (IN(0)) { if (G == 256) p0_fused(args, lds, vcu, gw, NGW, tid, wave, lane); else { p0_prologue(args, lds, gw, NGW, wave, lane); for (int u = vcu; u < 256; u += G) p0_wf_unit(args, lds, u, tid, lane, wave); } if (BOTH(0)) GRID_BAR(); } STAMP(0);

#ifndef MK_TBL_PRE
#define MK_TBL_PRE 0
#endif
constexpr int TBL_PRE = MK_TBL_PRE;
constexpr int TBL_SPLIT = 13312;
#define PH_GEMM1 \
    if (IN(1)) {    \
        pg8::Gemm g{(const bf16*)(ws + WS_H), (const bf16*)(ws + WS_WIN), T, 2560, 1024}; pg8::StaticOrder S; S.init(T, 2560, G, bx); \
        pg8::EpiProj E{(bf16*)(ws + WS_Q), (bf16*)(ws + WS_K), (bf16*)(ws + WS_VV), (bf16*)(ws + WS_UA), (bf16*)(ws + WS_VA), args.in[3], args.in[4]}; \
        if (G == 256 && bx >= 128) p0_tables(args, 0, TBL_PRE, (bx - 128) * NWAVES + wave, 128 * NWAVES, lane);     \
        pg8::gemm_phase<pg8::EpiProj, pg8::StaticOrder, MK_ALIGN1, MK_SP2>(lds + RING_OFF, g, S, E); \
        if (G == 256) { if (bx >= 128) p0_tables(args, TBL_PRE, TBL_SPLIT, (bx - 128) * NWAVES + wave, 128 * NWAVES, lane); else p0_tables(args, TBL_SPLIT, 16384, bx * NWAVES + wave, 128 * NWAVES, lane); } else p0_tables(args, 0, 16384, gw, NGW, lane); \
        if (BOTH(1)) GRID_BAR(); \
    }
#if (MK_DUP & 2)
    PH_GEMM1
#endif
    PH_GEMM1 STAMP(1);
    if (IN(2)) {
        if (G == 256) {
          AttnStage st; const int xb = vcu >> 5, r = vcu & 31;
#define AU_OF(k) ((((k) % 3) << 9) + xb * 64 + (4 * ((k) / 3) + (r >> 3)) * 8 + (r & 7))
          attn_issue(args, AU_OF(0), tid, st); attn_issue_q(args, AU_OF(0), tid, st);
          constexpr int NK = (MK_DUP & 4) ? 12 : 6;
          for (int k = 0; k < NK; ++k) {
              const int u = AU_OF(k % 6);
              attn_commit<true>(args, lds, u, tid, st);
              __syncthreads();
              if (k + 1 < NK) attn_issue(args, AU_OF((k + 1) % 6), tid, st);
              attn_compute<0, true>(args, lds, u, tid, lane, wave, k + 1 < NK ? AU_OF((k + 1) % 6) : -1, &st);
              __syncthreads();
#if defined(MK_ATTN_PACE)
              if ((MK_ATTN_PACE >> k) & 1) p7_pace((unsigned*)(ws + WS_CTL), (int)(bx & 7));
#endif
          }
#undef AU_OF
          for (int k = 0; k < 2; ++k) sgu_unit(args, lds, xb * 64 + r + 32 * k, tid, lane, wave);
        } else { AttnStage st; int u = vcu;
          if (u < 1536) attn_issue(args, u, tid, st);
          for (; u < 1536; u += G) {
              attn_commit(args, lds, u, tid, st);
              __syncthreads();
              if (u + G < 1536) attn_issue(args, u + G, tid, st);
              attn_compute(args, lds, u, tid, lane, wave);
              __syncthreads();
          }
          for (; u < 2048; u += G) sgu_unit(args, lds, u - 1536, tid, lane, wave); }
        if (BOTH(2)) GRID_BAR();
    } STAMP(2);
#if (MK_DUP & 8)
    if (IN(3)) { p3_merge(args, (vcu >> 5) * SEQ + (vcu & 31) * NWAVES + wave, ((vcu >> 5) + 1) * SEQ, 32 * NWAVES, lane); GRID_BAR(); }
#endif
    if (IN(3)) {
        if (G == 256) p3_merge(args, (vcu >> 5) * SEQ + (vcu & 31) * NWAVES + wave, ((vcu >> 5) + 1) * SEQ, 32 * NWAVES, lane); else p3_merge(args, gw, T, NGW, lane);
        if (BOTH(3)) GRID_BAR(); } STAMP(3);
#define PH_GEMM2 \
    if (IN(4)) {    \
        pg8::Gemm g{(const bf16*)(ws + WS_H), (const bf16*)(ws + WS_WOUT), T, 1024, 1024}; pg8::StaticOrder S; S.init(T, 1024, G, bx); \
        pg8::EpiOut E{args.in[0], args.out, (bf16*)(ws + WS_X1B), (float*)(ws + WS_ROWSQ), (bf16*)(ws + WS_X1LO_A), (bf16*)(ws + WS_X1LO_B)}; \
        pg8::gemm_phase<pg8::EpiOut, pg8::StaticOrder, true, MK_SP2>(lds + RING_OFF, g, S, E); \
        if (BOTH(4)) GRID_BAR(); \
    }
#if (MK_DUP & 16)
    PH_GEMM2
#endif
    PH_GEMM2 STAMP(4);
#ifdef MK_G3DELAY
#define G3DELAY if (bx >= 128) { for (int q_ = 0; q_ < MK_G3DELAY; ++q_) __builtin_amdgcn_s_sleep(127); }
#else
#define G3DELAY
#endif
#define PH_GEMM3 \
    if (IN(5)) {    \
        pg8::Gemm g{(const bf16*)(ws + WS_X1B), (const bf16*)(ws + WS_WQ), T, 2048, 1024}; pg8::StaticOrder S; S.init(T, 2048, G, bx); \
        pg8::EpiPQ E{(const float*)(ws + WS_ROWSQ), (bf16*)(ws + WS_PQ)}; \
        G3DELAY \
        pg8::gemm_phase<pg8::EpiPQ, pg8::StaticOrder, MK_ALIGN3, MK_SP2>(lds + RING_OFF, g, S, E); \
        if (BOTH(5)) GRID_BAR(); \
    }
#if (MK_DUP & 32)
    PH_GEMM3
#endif
    PH_GEMM3 STAMP(5);
    STAMP(6);
#if (MK_DUP & 128)
    if (IN(7)) { if (vcu < T / 64) p7_sliced<0>(args, lds, vcu, lane, wave, (float*)(ws + WS_PQ), bar); GRID_BAR(); }
#endif
    if (IN(7)) { if (vcu < T / 64) p7_sliced<0>(args, lds, vcu, lane, wave, args.out, bar); } STAMP(7);
#ifdef MK_STAMP
    if (gw == 0 && lane == 0) { asm volatile("s_waitcnt vmcnt(0)" ::: "memory"); args.out[0] += (float)(ts_[MK_STAMP + 1] - ts_[MK_STAMP]) * 0.01f; }
#endif
#ifdef MK_PROBE_PHASES
#ifndef MK_RT_VARIANT
#define MK_RT_VARIANT 0
#endif
    if (IN(10)) { if (vcu < T / 64) p7_sliced<MK_RT_VARIANT>(args, lds, vcu, lane, wave, (float*)(ws + WS_PQ), bar); }
    if (IN(12)) { p0_prologue(args, lds, gw, NGW, wave, lane); }
    if (IN(13)) { p3_merge(args, gw, T, NGW, lane); }
    if (IN(14)) { for (int u = vcu; u < 512; u += G) sgu_unit(args, lds, u, tid, lane, wave); }
#endif
#undef IN
#undef BOTH
#undef GRID_BAR
}

#ifndef MK_CUTS
#define MK_CUTS 0
#endif
static void mega_launch(void* const* d_in, void* d_out, void* d_ws, hipStream_t stream, int ph_lo, int ph_hi, bool cuts) {
    static int grid = 0;
    if (grid == 0) {
        int dev = 0, cus = 0, per_cu = 0;
        if (hipGetDevice(&dev) != hipSuccess || hipDeviceGetAttribute(&cus, hipDeviceAttributeMultiprocessorCount, dev) != hipSuccess) { fprintf(stderr, "kernel_launch: device query failed\n"); grid = -1; return; }
        if (hipFuncSetAttribute((const void*)mega_fwd, hipFuncAttributeMaxDynamicSharedMemorySize, LDS_BYTES) != hipSuccess) { fprintf(stderr, "kernel_launch: hipFuncSetAttribute failed\n"); grid = -1; return; }
        if (hipOccupancyMaxActiveBlocksPerMultiprocessor(&per_cu, (const void*)mega_fwd, NWAVES * 64, LDS_BYTES) != hipSuccess || per_cu < 1) fprintf(stderr, "kernel_launch: occupancy query reports %d\n", per_cu);
        (void)hipGetLastError();
        grid = cus;
    }
    if (grid < 0) return;
    Args a{};
    for (int i = 0; i < 17; ++i) a.in[i] = (const float*)d_in[i];
    a.out = (float*)d_out; a.ws = (unsigned char*)d_ws;
    if (!cuts) { (void)hipMemsetAsync((char*)d_ws + WS_CTL, 0, CTL_ZERO_BYTES, stream); a.ph_lo = ph_lo; a.ph_hi = ph_hi; hipLaunchKernelGGL(mega_fwd, dim3(grid), dim3(NWAVES * 64), LDS_BYTES, stream, a); }
    else for (int p = ph_lo; p < ph_hi; ++p) { (void)hipMemsetAsync((char*)d_ws + WS_CTL, 0, CTL_ZERO_BYTES, stream); a.ph_lo = p; a.ph_hi = p + 1; hipLaunchKernelGGL(mega_fwd, dim3(grid), dim3(NWAVES * 64), LDS_BYTES, stream, a); }
    const hipError_t le = hipPeekAtLastError();
    if (le != hipSuccess) fprintf(stderr, "kernel_launch: launch failed: %s\n", hipGetErrorName(le));
}

extern "C" void kernel_launch(void* const* d_in, const int* in_sizes, int n_in, void* d_out, int out_size, void* d_ws, size_t ws_size, hipStream_t stream) {
    mega_launch(d_in, d_out, d_ws, stream, 0, 8, MK_CUTS != 0);
}
```
